# Optimizing an MI355X kernel written in HIP

```python
import jax, jax.numpy as jnp
from jax import lax
import numpy as np

D_MODEL = 1024
BATCH = 32
SEQ = 2048
DEPTH = 1

CHUNK = 64
N_META = 16
EPS = 1e-6
POOL_WIDTH = 512
POOL_GROUPS = 4
POOL_GROUP_DIM = POOL_WIDTH // POOL_GROUPS
POOL_WINDOWS = (2, 4, 8, 16)
GLA_HEADS = 4
GLA_DK = 64
GLA_DV = 128
GLA_KEY = GLA_HEADS * GLA_DK
GLA_VAL = GLA_HEADS * GLA_DV
GLA_GATE_RANK = 16
GLA_TAU = 16.0
D_FF = 4 * D_MODEL
IN_SIZES = (POOL_WIDTH, GLA_KEY, GLA_KEY, GLA_VAL, GLA_VAL, GLA_GATE_RANK, D_MODEL, D_MODEL)
N_IN = sum(IN_SIZES)
IN_SPLITS = [int(s) for s in np.cumsum(IN_SIZES)[:-1]]

kernel_name = "hybrid_pool_gla_gated_block"


def rmsnorm(x, g):
    xf = x.astype(jnp.float32)
    y = xf * lax.rsqrt(jnp.mean(xf * xf, axis=-1, keepdims=True) + EPS)
    return (y * g.astype(jnp.float32)).astype(x.dtype)


def multiscale_pool(a):
    B, L, _ = a.shape
    af = a.astype(jnp.float32)
    cs = jnp.concatenate([jnp.zeros((B, 1, POOL_WIDTH), jnp.float32), jnp.cumsum(af, axis=1)], axis=1)
    t = jnp.arange(L)
    outs = []
    for g, w in enumerate(POOL_WINDOWS):
        lo_c, hi_c = g * POOL_GROUP_DIM, (g + 1) * POOL_GROUP_DIM
        hi = cs[:, 1:, lo_c:hi_c]
        lo = jnp.concatenate([jnp.zeros((B, w - 1, POOL_GROUP_DIM), jnp.float32), cs[:, :L - w + 1, lo_c:hi_c]], axis=1)
        cnt = jnp.minimum(t + 1, w).astype(jnp.float32)[None, :, None]
        outs.append((hi - lo) / cnt)
    return (jnp.concatenate(outs, axis=-1) - af).astype(a.dtype)


def gla_chunk_step(S, inp):
    qc, kc, vc, ac = inp
    b = jnp.cumsum(ac, axis=2)
    decay = jnp.exp(-jnp.abs(b[:, :, :, None, :] - b[:, :, None, :, :]))
    scores = jnp.einsum('bhtk,bhsk,bhtsk->bhts', qc, kc, decay)
    o = jnp.einsum('bhts,bhsv->bhtv', scores, vc) + jnp.einsum('bhtk,bhkv->bhtv', qc * jnp.exp(b), S)
    b_end = b[:, :, -1:, :]
    S_new = jnp.exp(b_end[:, :, 0, :])[..., None] * S + jnp.einsum('bhsk,bhsv->bhkv', kc * jnp.exp(b_end - b), vc)
    return S_new, o


def gla_chunked(q, k, v, log_a):
    B = q.shape[0]
    pad = CHUNK - N_META

    def prep(t):
        t = jnp.pad(t.astype(jnp.float32), ((0, 0), (pad, 0), (0, 0), (0, 0)))
        n = t.shape[1] // CHUNK
        return t.reshape(B, n, CHUNK, GLA_HEADS, t.shape[-1]).transpose(1, 0, 3, 2, 4)

    qc, kc, vc, ac = prep(q), prep(k), prep(v), prep(log_a)
    S0 = jnp.zeros((B, GLA_HEADS, GLA_DK, GLA_DV), jnp.float32)
    _, o = lax.scan(gla_chunk_step, S0, (qc, kc, vc, ac))
    o = o.transpose(1, 0, 3, 2, 4).reshape(B, -1, GLA_HEADS, GLA_DV)[:, pad:]
    return o.astype(v.dtype)


def hybrid_mixer(u, w_in, w_pool_mix, pool_scale, w_pool_out, w_gate_up, b_gate, gla_norm, w_gla_out, w_out):
    B, L, _ = u.shape
    z = jnp.einsum('bld,dn->bln', u, w_in)
    a, q, k, v, r, lr, ga, gb = jnp.split(z, IN_SPLITS, axis=-1)
    p = multiscale_pool(a).reshape(B, L, POOL_GROUPS, POOL_GROUP_DIM)
    p = jnp.einsum('blgc,gce->blge', p, w_pool_mix).reshape(B, L, POOL_WIDTH) * pool_scale
    y_a = jnp.einsum('blc,cd->bld', p, w_pool_out)
    log_a = jax.nn.log_sigmoid((lr @ w_gate_up + b_gate).astype(jnp.float32)) / GLA_TAU
    q = q.reshape(B, L, GLA_HEADS, GLA_DK) * (GLA_DK ** -0.5)
    k = k.reshape(B, L, GLA_HEADS, GLA_DK)
    v = v.reshape(B, L, GLA_HEADS, GLA_DV)
    log_a = log_a.reshape(B, L, GLA_HEADS, GLA_DK)
    o = gla_chunked(q, k, v, log_a)
    o = rmsnorm(o, gla_norm.reshape(GLA_HEADS, GLA_DV)) * jax.nn.silu(r).reshape(B, L, GLA_HEADS, GLA_DV)
    y_b = jnp.einsum('blc,cd->bld', o.reshape(B, L, GLA_VAL), w_gla_out)
    m = jax.nn.sigmoid(ga) * y_a + jax.nn.sigmoid(gb) * y_b
    return jnp.einsum('bld,de->ble', m, w_out)


def squared_relu_mlp(u, w_ff1, w_ff2):
    hdn = jnp.square(jax.nn.relu(jnp.einsum('bld,df->blf', u, w_ff1)))
    return jnp.einsum('blf,fd->bld', hdn, w_ff2)


def setup_inputs(seed: int = 0) -> dict:
    key = jax.random.key(seed)
    ks = jax.random.split(key, 20)
    f32 = jnp.float32
    nrm = lambda k, shape, s: jax.random.normal(k, shape, f32) * s
    return {
        "x": jax.random.normal(ks[0], (BATCH, SEQ, D_MODEL), f32),
        "meta_tokens": nrm(ks[1], (N_META, D_MODEL), 1.0),
        "norm_mix": 1.0 + nrm(ks[2], (DEPTH, D_MODEL), 0.05),
        "w_in": nrm(ks[3], (DEPTH, D_MODEL, N_IN), D_MODEL ** -0.5),
        "w_pool_mix": nrm(ks[4], (DEPTH, POOL_GROUPS, POOL_GROUP_DIM, POOL_GROUP_DIM), POOL_GROUP_DIM ** -0.5),
        "pool_scale": 1.0 + nrm(ks[5], (DEPTH, POOL_WIDTH), 0.1),
        "w_pool_out": nrm(ks[6], (DEPTH, POOL_WIDTH, D_MODEL), POOL_WIDTH ** -0.5),
        "w_gate_up": nrm(ks[7], (DEPTH, GLA_GATE_RANK, GLA_KEY), GLA_GATE_RANK ** -0.5),
        "b_gate": nrm(ks[8], (DEPTH, GLA_KEY), 0.1),
        "gla_norm": 1.0 + nrm(ks[9], (DEPTH, GLA_VAL), 0.05),
        "w_gla_out": nrm(ks[10], (DEPTH, GLA_VAL, D_MODEL), GLA_VAL ** -0.5),
        "w_out": nrm(ks[11], (DEPTH, D_MODEL, D_MODEL), D_MODEL ** -0.5),
        "norm_ffn": 1.0 + nrm(ks[12], (DEPTH, D_MODEL), 0.05),
        "w_ff1": nrm(ks[13], (DEPTH, D_MODEL, D_FF), D_MODEL ** -0.5),
        "w_ff2": nrm(ks[14], (DEPTH, D_FF, D_MODEL), D_FF ** -0.5),
        "norm_final": 1.0 + nrm(ks[15], (D_MODEL,), 0.05),
    }


def reference(x, meta_tokens, norm_mix, w_in, w_pool_mix, pool_scale, w_pool_out, w_gate_up, b_gate,
              gla_norm, w_gla_out, w_out, norm_ffn, w_ff1, w_ff2, norm_final):
    B = x.shape[0]
    meta = jnp.broadcast_to(meta_tokens[None].astype(x.dtype), (B, N_META, D_MODEL))
    h = jnp.concatenate([meta, x], axis=1)
    for l in range(DEPTH):
        h = h + hybrid_mixer(rmsnorm(h, norm_mix[l]), w_in[l], w_pool_mix[l], pool_scale[l], w_pool_out[l],
                             w_gate_up[l], b_gate[l], gla_norm[l], w_gla_out[l], w_out[l])
        h = h + squared_relu_mlp(rmsnorm(h, norm_ffn[l]), w_ff1[l], w_ff2[l])
    return rmsnorm(h, norm_final)[:, N_META:]
```

```cpp
#include <hip/hip_runtime.h>
#include <hip/hip_cooperative_groups.h>
#include <cstdio>
#include <cstdint>
namespace cg = cooperative_groups;

#ifndef MK_N_LAUNCHES
#define MK_N_LAUNCHES 1
#endif

namespace pg8 {
#define PG8_LAS __attribute__((address_space(3)))
typedef unsigned short bf16_t;
typedef short bf16x8 __attribute__((ext_vector_type(8)));
typedef float f32x4 __attribute__((ext_vector_type(4)));
typedef unsigned u32x4 __attribute__((ext_vector_type(4)));
constexpr int BM = 256, BK = 64, HALF = 128, HTB = HALF * BK * 2  , STAGE_BYTES = 8 * HTB, NXCD = 8, WGM = 8;

__host__ __device__ __forceinline__ int lds_byte(int r, int c) { const int st = (r >> 4) * 2 + (c >> 5), rr = r & 15, cc = c & 31, ob = rr * 64 + cc * 2; return st * 1024 + (ob ^ (((ob >> 9) & 1) << 5)); }
__host__ __device__ __forceinline__ void stage_rc(int b, int& R, int& C) { const int st = b / 1024, sb = b % 1024, swz = sb ^ (((sb >> 9) & 1) << 5); R = (st >> 1) * 16 + swz / 64; C = (st & 1) * 32 + (swz % 64) / 2; }
__host__ __device__ __forceinline__ int perm32(int rho) { const int n = rho >> 4, i = rho & 15; return 8 * (i >> 2) + 4 * n + (i & 3); }

struct Unit { int pm, pn; };
struct Gemm { const bf16_t* A; const bf16_t* Bt; int M, N, K; };

struct StaticOrder {
    int nM, nN, nwg, G, c;
    __host__ __device__ void init(int M, int N, int G_, int c_) { nM = M / BM; nN = N / BM; nwg = nM * nN; G = G_; c = c_; }
    __host__ __device__ bool next(int i, Unit& u) const {
        const long L = (long)i * G + c; if (L >= nwg) return false;
        int wgid = (int)L; { const int q = nwg / NXCD, r = nwg % NXCD, xcd = wgid % NXCD, off = wgid / NXCD; wgid = (xcd < r ? xcd * (q + 1) : r * (q + 1) + (xcd - r) * q) + off; }
        const int nig = WGM * nN, gid = wgid / nig, fm = gid * WGM, gsz = (nM - fm) < WGM ? (nM - fm) : WGM;
        u.pm = fm + ((wgid % nig) % gsz); u.pn = (wgid % nig) / gsz; return true;
    }
    __device__ __forceinline__ void a_ready(const Unit&) const {}
    __device__ __forceinline__ void done(const Unit&) const {}
};

typedef float f32x2_t __attribute__((ext_vector_type(2))); typedef __bf16 bf16x2_t __attribute__((ext_vector_type(2)));
__device__ __forceinline__ unsigned cvt_pk_bf16(float lo, float hi) { f32x2_t v = {lo, hi}; bf16x2_t b = __builtin_convertvector(v, bf16x2_t); return __builtin_bit_cast(unsigned, b); }
typedef unsigned u32x2 __attribute__((ext_vector_type(2)));
__device__ __forceinline__ float bf_lo(unsigned w) { return __uint_as_float(w << 16); }
__device__ __forceinline__ float bf_hi(unsigned w) { return __uint_as_float(w & 0xffff0000u); }
__device__ __forceinline__ float sigm(float v) { return __builtin_amdgcn_rcpf(1.0f + __expf(-v)); }
__device__ __forceinline__ float logsig(float v) { return fminf(v, 0.f) - __logf(1.0f + __expf(-fabsf(v))); }
__device__ __forceinline__ u32x4 pack8(f32x4 v0, f32x4 v1) { u32x4 w; w.x = cvt_pk_bf16(v0[0], v0[1]); w.y = cvt_pk_bf16(v0[2], v0[3]); w.z = cvt_pk_bf16(v1[0], v1[1]); w.w = cvt_pk_bf16(v1[2], v1[3]); return w; }

struct EpiZ {
    static constexpr bool PERM = true, AFTER_DRAIN = false;
    bf16_t* Ab; bf16_t* Qb; bf16_t* Kb; bf16_t* Vb; bf16_t* Rb; float* LAb; bf16_t* GAb; bf16_t* GBb; const float* bgate;
    template <int MODE> __device__ __forceinline__ void put(const f32x4 (&acc)[2][2][4][2], bf16_t* base, int ldc, int row0, int col0) const {
#pragma unroll
        for (int ai = 0; ai < 2; ++ai)
#pragma unroll
            for (int m = 0; m < 4; ++m) { bf16_t* rowp = base + (size_t)(row0 + ai * HALF + m * 16) * ldc + col0;
#pragma unroll
                for (int bj = 0; bj < 2; ++bj) { f32x4 v0 = acc[ai][bj][m][0], v1 = acc[ai][bj][m][1];
                    if (MODE == 1) { v0 = v0 * 0.125f; v1 = v1 * 0.125f; }
                    if (MODE == 2) {
#pragma unroll
                        for (int e = 0; e < 4; ++e) { v0[e] = v0[e] * sigm(v0[e]); v1[e] = v1[e] * sigm(v1[e]); } }
                    if (MODE == 3) {
#pragma unroll
                        for (int e = 0; e < 4; ++e) { v0[e] = sigm(v0[e]); v1[e] = sigm(v1[e]); } }
                    *(u32x4*)(rowp + bj * HALF) = pack8(v0, v1); } }
    }
    __device__ __forceinline__ void operator()(const f32x4 (&acc)[2][2][4][2], const Unit& u, int wr, int wc, int fr, int fq) const {
        const int pn = u.pn, row0 = u.pm * BM + wr * 64 + fr, cl = wc * 32 + 8 * fq;
        if (pn < 2) put<0>(acc, Ab, 512, row0, pn * 256 + cl);
        else if (pn == 2) put<1>(acc, Qb, 256, row0, cl);
        else if (pn == 3) put<0>(acc, Kb, 256, row0, cl);
        else if (pn < 6) put<0>(acc, Vb, 512, row0, (pn - 4) * 256 + cl);
        else if (pn < 8) put<2>(acc, Rb, 512, row0, (pn - 6) * 256 + cl);
        else if (pn == 8) {
#pragma unroll
            for (int bj = 0; bj < 2; ++bj) { const f32x4 b0 = *(const f32x4*)(bgate + cl + bj * HALF), b1 = *(const f32x4*)(bgate + cl + bj * HALF + 4);
#pragma unroll
                for (int ai = 0; ai < 2; ++ai)
#pragma unroll
                    for (int m = 0; m < 4; ++m) { float* p = LAb + (size_t)(row0 + ai * HALF + m * 16) * 256 + cl + bj * HALF;
                        f32x4 v0 = acc[ai][bj][m][0] + b0, v1 = acc[ai][bj][m][1] + b1;
#pragma unroll
                        for (int e = 0; e < 4; ++e) { v0[e] = logsig(v0[e]) * 0.0625f; v1[e] = logsig(v1[e]) * 0.0625f; }
                        *(f32x4*)p = v0; *(f32x4*)(p + 4) = v1; } }
        }
        else if (pn < 13) put<3>(acc, GAb, 1024, row0, (pn - 9) * 256 + cl);
        else put<3>(acc, GBb, 1024, row0, (pn - 13) * 256 + cl);
    }
};
template <bool ADD> struct EpiGate {
    static constexpr bool PERM = true, AFTER_DRAIN = false;
    const bf16_t* G; bf16_t* O;
    __device__ __forceinline__ void operator()(const f32x4 (&acc)[2][2][4][2], const Unit& u, int wr, int wc, int fr, int fq) const {
        const int row0 = u.pm * BM + wr * 64 + fr, col0 = u.pn * BM + wc * 32 + 8 * fq;
#pragma unroll
        for (int ai = 0; ai < 2; ++ai)
#pragma unroll
            for (int m = 0; m < 4; ++m) { const size_t ro = (size_t)(row0 + ai * HALF + m * 16) * 1024 + col0;
#pragma unroll
                for (int bj = 0; bj < 2; ++bj) { const u32x4 g = *(const u32x4*)(G + ro + bj * HALF);
                    f32x4 v0 = acc[ai][bj][m][0], v1 = acc[ai][bj][m][1];
                    v0 = v0 * (f32x4){bf_lo(g.x), bf_hi(g.x), bf_lo(g.y), bf_hi(g.y)}; v1 = v1 * (f32x4){bf_lo(g.z), bf_hi(g.z), bf_lo(g.w), bf_hi(g.w)};
                    if (ADD) { const u32x4 t = *(const u32x4*)(O + ro + bj * HALF);
                        v0 = v0 + (f32x4){bf_lo(t.x), bf_hi(t.x), bf_lo(t.y), bf_hi(t.y)}; v1 = v1 + (f32x4){bf_lo(t.z), bf_hi(t.z), bf_lo(t.w), bf_hi(t.w)}; }
                    *(u32x4*)(O + ro + bj * HALF) = pack8(v0, v1); } }
    }
};
struct EpiOut {
    static constexpr bool PERM = true, AFTER_DRAIN = false;
    const float* X; float* H; bf16_t* U2; const float* g; float* ssq;
    __device__ __forceinline__ void operator()(const f32x4 (&acc)[2][2][4][2], const Unit& u, int wr, int wc, int fr, int fq) const {
        const int row0 = u.pm * BM + wr * 64 + fr, col0 = u.pn * BM + wc * 32 + 8 * fq;
        f32x4 gv[2][2];
#pragma unroll
        for (int bj = 0; bj < 2; ++bj)
#pragma unroll
            for (int n = 0; n < 2; ++n) gv[bj][n] = *(const f32x4*)(g + col0 + bj * HALF + 4 * n);
#pragma unroll
        for (int ai = 0; ai < 2; ++ai)
#pragma unroll
            for (int m = 0; m < 4; ++m) { const int row = row0 + ai * HALF + m * 16; const size_t ro = (size_t)row * 1024 + col0; float s = 0.f;
#pragma unroll
                for (int bj = 0; bj < 2; ++bj) { const f32x4 x0 = *(const f32x4*)(X + ro + bj * HALF), x1 = *(const f32x4*)(X + ro + bj * HALF + 4);
                    const f32x4 h0 = x0 + acc[ai][bj][m][0], h1 = x1 + acc[ai][bj][m][1];
                    *(f32x4*)(H + ro + bj * HALF) = h0; *(f32x4*)(H + ro + bj * HALF + 4) = h1;
                    s += (h0[0] * h0[0] + h0[1] * h0[1]) + (h0[2] * h0[2] + h0[3] * h0[3]) + (h1[0] * h1[0] + h1[1] * h1[1]) + (h1[2] * h1[2] + h1[3] * h1[3]);
                    *(u32x4*)(U2 + ro + bj * HALF) = pack8(h0 * gv[bj][0], h1 * gv[bj][1]); }
                s += __shfl_xor(s, 16); s += __shfl_xor(s, 32);
                if (fq == 0) ssq[(size_t)row * 16 + u.pn * 4 + wc] = s; }
    }
};
struct EpiFF1 {
    static constexpr bool PERM = true, AFTER_DRAIN = false;
    const float* ssq; bf16_t* Hd;
    __device__ __forceinline__ void operator()(const f32x4 (&acc)[2][2][4][2], const Unit& u, int wr, int wc, int fr, int fq) const {
        const int row0 = u.pm * BM + wr * 64 + fr, col0 = u.pn * BM + wc * 32 + 8 * fq;
#pragma unroll
        for (int ai = 0; ai < 2; ++ai)
#pragma unroll
            for (int m = 0; m < 4; ++m) { const int row = row0 + ai * HALF + m * 16;
                const f32x4 p = *(const f32x4*)(ssq + (size_t)row * 16 + 4 * fq); float s = (p[0] + p[1]) + (p[2] + p[3]);
                s += __shfl_xor(s, 16); s += __shfl_xor(s, 32);
                const float rstd = __builtin_amdgcn_rsqf(s * (1.0f / 1024.0f) + 1e-6f);
#pragma unroll
                for (int bj = 0; bj < 2; ++bj) { f32x4 v0 = acc[ai][bj][m][0] * rstd, v1 = acc[ai][bj][m][1] * rstd;
#pragma unroll
                    for (int e = 0; e < 4; ++e) { const float a = fmaxf(v0[e], 0.f), b = fmaxf(v1[e], 0.f); v0[e] = a * a; v1[e] = b * b; }
                    *(u32x4*)(Hd + (size_t)row * 4096 + col0 + bj * HALF) = pack8(v0, v1); } }
    }
};
struct EpiFF2 {
    static constexpr bool PERM = true, AFTER_DRAIN = false;
    float* H;
    __device__ __forceinline__ void operator()(const f32x4 (&acc)[2][2][4][2], const Unit& u, int wr, int wc, int fr, int fq) const {
        const int row0 = u.pm * BM + wr * 64 + fr, col0 = u.pn * BM + wc * 32 + 8 * fq;
#pragma unroll
        for (int ai = 0; ai < 2; ++ai)
#pragma unroll
            for (int m = 0; m < 4; ++m) { const size_t ro = (size_t)(row0 + ai * HALF + m * 16) * 1024 + col0;
#pragma unroll
                for (int bj = 0; bj < 2; ++bj) { float* p = H + ro + bj * HALF; const f32x4 x0 = *(const f32x4*)p, x1 = *(const f32x4*)(p + 4);
                    *(f32x4*)p = x0 + acc[ai][bj][m][0]; *(f32x4*)(p + 4) = x1 + acc[ai][bj][m][1]; } }
    }
};

template <class Epi, class Sched, bool ALIGN_EPI = false, bool SP2 = false>
__device__ __forceinline__ void gemm_phase(PG8_LAS unsigned char* lds, const Gemm g, const Sched& S, const Epi& E) {
    const int tid = threadIdx.x, wid = __builtin_amdgcn_readfirstlane(tid >> 6), lane = tid & 63, wr = wid >> 2, wc = wid & 3, fr = lane & 15, fq = lane >> 4;
    const int K = g.K, nt = K / BK;
    unsigned voffA[2], voffB[2];
#pragma unroll
    for (int i = 0; i < 2; ++i) { int R, C; stage_rc(tid * 16 + i * 8192, R, C); const int Rb = Epi::PERM ? ((R & ~31) + perm32(R & 31)) : R;
        voffA[i] = (unsigned)(R * K + C) * 2u; voffB[i] = (unsigned)(Rb * K + C) * 2u; }
    const size_t kstep = (size_t)(BK * 2);
    const size_t hstep = (size_t)HALF * K * 2;
    const size_t tstep = 2 * hstep;
    const unsigned ldsw = (unsigned)wid * 1024u;
    const int aoff = lds_byte(wr * 64 + fr, fq * 8), boff = lds_byte(wc * 32 + fr, fq * 8);
#define PG8_SA(b, h) (((b) * 2 + (h)) * HTB)
#define PG8_SB(b, h) ((4 + (b) * 2 + (h)) * HTB)
#define PG8_STAGE(bufoff, gbase, voff) do { _Pragma("unroll") for (int _i = 0; _i < 2; ++_i) \
        __builtin_amdgcn_global_load_lds((const unsigned*)((const char*)(gbase) + (voff)[_i]), (PG8_LAS unsigned*)(lds + (bufoff) + ldsw + _i * 8192), 16, 0, 0); } while (0)
#define PG8_LDA(dst, b, h) do { _Pragma("unroll") for (int m = 0; m < 4; ++m) _Pragma("unroll") for (int k = 0; k < 2; ++k) dst[m][k] = *(const PG8_LAS bf16x8*)(lds + PG8_SA(b, h) + aoff + m * 2048 + k * 1024); } while (0)
#define PG8_LDB(dst, b, h) do { _Pragma("unroll") for (int n = 0; n < 2; ++n) _Pragma("unroll") for (int k = 0; k < 2; ++k) dst[n][k] = *(const PG8_LAS bf16x8*)(lds + PG8_SB(b, h) + boff + n * 2048 + k * 1024); } while (0)
#define PG8_MMA(ai, bj, At, Bt) do { __builtin_amdgcn_s_setprio(1); _Pragma("unroll") for (int m = 0; m < 4; ++m) _Pragma("unroll") for (int n = 0; n < 2; ++n) _Pragma("unroll") for (int k = 0; k < 2; ++k) \
        acc[ai][bj][m][n] = __builtin_amdgcn_mfma_f32_16x16x32_bf16(Bt[n][k], At[m][k], acc[ai][bj][m][n], 0, 0, 0); __builtin_amdgcn_s_setprio(0); } while (0)
#define PG8_WAIT_V(n) asm volatile("s_waitcnt vmcnt(" #n ")" ::: "memory")
#define PG8_WAIT_L(n) asm volatile("s_waitcnt lgkmcnt(" #n ")" ::: "memory")
#define PG8_BAR __builtin_amdgcn_s_barrier()
#define PG8_SCHED __builtin_amdgcn_sched_barrier(0)
    Unit cur, nxt; int ui = 0;
    if (!S.next(0, cur)) return;
    f32x4 acc[2][2][4][2];
#pragma unroll
    for (int a = 0; a < 2; ++a)
#pragma unroll
        for (int b = 0; b < 2; ++b)
#pragma unroll
            for (int m = 0; m < 4; ++m)
#pragma unroll
                for (int n = 0; n < 2; ++n) acc[a][b][m][n] = (f32x4){0.f, 0.f, 0.f, 0.f};
    bf16x8 At[4][2], B0[2][2], B1[2][2];
    const char* cA = (const char*)g.A + (size_t)cur.pm * tstep; const char* cB = (const char*)g.Bt + (size_t)cur.pn * tstep;
    S.a_ready(cur);
    if constexpr (SP2) {
        PG8_STAGE(PG8_SB(0, 0), cB, voffB); PG8_STAGE(PG8_SB(0, 1), cB + hstep, voffB); PG8_STAGE(PG8_SA(0, 0), cA, voffA); PG8_STAGE(PG8_SA(0, 1), cA + hstep, voffA);
        if (wr == 1) PG8_BAR;
        PG8_WAIT_V(2); PG8_BAR;
        PG8_STAGE(PG8_SB(1, 0), cB + kstep, voffB); PG8_STAGE(PG8_SA(1, 0), cA + kstep, voffA); PG8_STAGE(PG8_SB(1, 1), cB + hstep + kstep, voffB);
        PG8_WAIT_V(6); PG8_BAR;
    } else {
        PG8_STAGE(PG8_SB(0, 0), cB, voffB); PG8_STAGE(PG8_SA(0, 0), cA, voffA); PG8_STAGE(PG8_SB(0, 1), cB + hstep, voffB); PG8_STAGE(PG8_SA(0, 1), cA + hstep, voffA);
        if (wr == 1) PG8_BAR;
        PG8_WAIT_V(4); PG8_BAR;
        PG8_STAGE(PG8_SB(1, 0), cB + kstep, voffB); PG8_STAGE(PG8_SA(1, 0), cA + kstep, voffA); PG8_STAGE(PG8_SB(1, 1), cB + hstep + kstep, voffB);
        PG8_WAIT_V(6); PG8_BAR;
    }
    for (;;) {
        const bool has_next = S.next(ui + 1, nxt);
        const char* nA = has_next ? (const char*)g.A + (size_t)nxt.pm * tstep : cA; const char* nB = has_next ? (const char*)g.Bt + (size_t)nxt.pn * tstep : cB;
        for (int t = 0; t < nt; t += 2) {
            const bool last = (t == nt - 2);
            const char* a1 = cA + (size_t)(t + 1) * kstep;
            const char* a2 = last ? nA : cA + (size_t)(t + 2) * kstep; const char* b2 = last ? nB : cB + (size_t)(t + 2) * kstep;
            const char* a3 = a2 + kstep; const char* b3 = b2 + kstep;
            if (last && has_next) S.a_ready(nxt);
            if constexpr (SP2) {
            PG8_LDB(B0, 0, 0); PG8_LDB(B1, 0, 1); PG8_SCHED; PG8_LDA(At, 0, 0); PG8_STAGE(PG8_SA(1, 1), a1 + hstep, voffA);
            PG8_WAIT_V(8); PG8_WAIT_L(0); PG8_BAR; PG8_MMA(0, 0, At, B0); PG8_MMA(0, 1, At, B1); PG8_BAR; PG8_SCHED;
            PG8_LDA(At, 0, 1); PG8_STAGE(PG8_SB(0, 0), b2, voffB); PG8_STAGE(PG8_SB(0, 1), b2 + hstep, voffB); PG8_STAGE(PG8_SA(0, 0), a2, voffA);
            PG8_WAIT_V(8); PG8_WAIT_L(0); PG8_BAR; PG8_MMA(1, 0, At, B0); PG8_MMA(1, 1, At, B1); PG8_BAR; PG8_SCHED;
            PG8_LDB(B0, 1, 0); PG8_LDB(B1, 1, 1); PG8_SCHED; PG8_LDA(At, 1, 0); PG8_STAGE(PG8_SA(0, 1), a2 + hstep, voffA);
            PG8_WAIT_V(8); PG8_WAIT_L(0); PG8_BAR; PG8_MMA(0, 0, At, B0); PG8_MMA(0, 1, At, B1); PG8_BAR; PG8_SCHED;
            PG8_LDA(At, 1, 1); PG8_STAGE(PG8_SB(1, 0), b3, voffB); PG8_STAGE(PG8_SB(1, 1), b3 + hstep, voffB); PG8_STAGE(PG8_SA(1, 0), a3, voffA);
            PG8_WAIT_V(8); PG8_WAIT_L(0); PG8_BAR; PG8_MMA(1, 0, At, B0); PG8_MMA(1, 1, At, B1); PG8_BAR; PG8_SCHED;
            } else {
            PG8_LDB(B0, 0, 0); PG8_SCHED; PG8_LDA(At, 0, 0); PG8_STAGE(PG8_SA(1, 1), a1 + hstep, voffA);
            PG8_WAIT_L(8); PG8_BAR; PG8_WAIT_L(0); PG8_MMA(0, 0, At, B0); PG8_BAR; PG8_SCHED;
            PG8_LDB(B1, 0, 1); PG8_STAGE(PG8_SB(0, 0), b2, voffB);
            PG8_BAR; PG8_WAIT_L(0); PG8_MMA(0, 1, At, B1); PG8_BAR;
            PG8_LDA(At, 0, 1); PG8_STAGE(PG8_SA(0, 0), a2, voffA);
            PG8_BAR; PG8_WAIT_L(0); PG8_MMA(1, 0, At, B0); PG8_BAR; PG8_SCHED;
            PG8_STAGE(PG8_SB(0, 1), b2 + hstep, voffB);
            PG8_WAIT_V(6); PG8_BAR; PG8_MMA(1, 1, At, B1); PG8_BAR;
            PG8_LDB(B0, 1, 0); PG8_SCHED; PG8_LDA(At, 1, 0); PG8_STAGE(PG8_SA(0, 1), a2 + hstep, voffA);
            PG8_WAIT_L(8); PG8_BAR; PG8_WAIT_L(0); PG8_MMA(0, 0, At, B0); PG8_BAR; PG8_SCHED;
            PG8_LDB(B1, 1, 1); PG8_STAGE(PG8_SB(1, 0), b3, voffB);
            PG8_BAR; PG8_WAIT_L(0); PG8_MMA(0, 1, At, B1); PG8_BAR;
            PG8_LDA(At, 1, 1); PG8_STAGE(PG8_SA(1, 0), a3, voffA);
            PG8_BAR; PG8_WAIT_L(0); PG8_MMA(1, 0, At, B0); PG8_BAR; PG8_SCHED;
            PG8_STAGE(PG8_SB(1, 1), b3 + hstep, voffB);
            PG8_WAIT_V(6); PG8_BAR; PG8_MMA(1, 1, At, B1); PG8_BAR;
            }
        }
        if constexpr (ALIGN_EPI) { if (wr == 0) PG8_BAR; }
        if constexpr (!Epi::AFTER_DRAIN) { E(acc, cur, wr, wc, fr, fq); S.done(cur); }
        if (!has_next) break;
#pragma unroll
        for (int a = 0; a < 2; ++a)
#pragma unroll
            for (int b = 0; b < 2; ++b)
#pragma unroll
                for (int m = 0; m < 4; ++m)
#pragma unroll
                    for (int n = 0; n < 2; ++n) acc[a][b][m][n] = (f32x4){0.f, 0.f, 0.f, 0.f};
        cur = nxt; cA = nA; cB = nB; ++ui;
        if constexpr (ALIGN_EPI) { if (wr == 1) PG8_BAR; }
    }
    PG8_WAIT_V(0);
    if constexpr (!ALIGN_EPI) { if (wr == 0) PG8_BAR; }
    PG8_BAR;
    if constexpr (Epi::AFTER_DRAIN) { E.fused(acc, cur, wr, wc, fr, fq, lds, wid, lane); S.done(cur); }
#undef PG8_SA
#undef PG8_SB
#undef PG8_STAGE
#undef PG8_LDA
#undef PG8_LDB
#undef PG8_MMA
#undef PG8_WAIT_V
#undef PG8_WAIT_L
#undef PG8_BAR
#undef PG8_SCHED
}
}
#ifndef PG8_SP2
#define PG8_SP2 true
#endif
#ifndef PG8_ALIGN
#define PG8_ALIGN true
#endif

constexpr int NWAVES = 8, NTHR = NWAVES * 64;
constexpr int D = 1024, BATCH = 32, SEQ = 2048, T = BATCH * SEQ, TP = T + 256, NZ = 4352, FF = 4096, W_IN_LD = 4112;
constexpr int NCHUNK = SEQ / 64;
constexpr int META_PAD = 48;
constexpr float EPS = 1e-6f;
constexpr size_t MiB = 1u << 20;
constexpr size_t WS_WIN = 0, WS_WA = 9 * MiB, WS_WB = 10 * MiB, WS_WO = 11 * MiB, WS_W1 = 13 * MiB, WS_W2 = 21 * MiB;
constexpr size_t WS_SSQ = 30 * MiB;
constexpr size_t WS_U = 34 * MiB;
constexpr size_t WS_Z = 163 * MiB;
constexpr size_t ZROW = (size_t)TP;
constexpr size_t WS_A = WS_Z, WS_Q = WS_A + ZROW * 512 * 2, WS_K = WS_Q + ZROW * 256 * 2, WS_V = WS_K + ZROW * 256 * 2, WS_R = WS_V + ZROW * 512 * 2,
                 WS_LA = WS_R + ZROW * 512 * 2, WS_GA = WS_LA + ZROW * 256 * 4, WS_GB = WS_GA + ZROW * 1024 * 2, WS_ZEND = WS_GB + ZROW * 1024 * 2;
constexpr size_t WS_PA = 742 * MiB, WS_ON = 806 * MiB, WS_U2 = 870 * MiB, WS_END = 998 * MiB;
constexpr size_t WS_HD = WS_Z;
static_assert(WS_ZEND <= WS_PA && WS_HD + (size_t)T * FF * 2 <= WS_PA && WS_U + ZROW * 2048 <= WS_Z, "ws map");
constexpr int LDS_BYTES = 132096;

#define GAS __attribute__((address_space(1)))
#define LAS __attribute__((address_space(3)))
typedef unsigned short bf16;
typedef unsigned v4u __attribute__((ext_vector_type(4)));
typedef unsigned v2u __attribute__((ext_vector_type(2)));
typedef float f32x4 __attribute__((ext_vector_type(4)));
typedef short bf16x8 __attribute__((ext_vector_type(8)));
using pg8::cvt_pk_bf16; using pg8::bf_lo; using pg8::bf_hi;
#define LDS_WAIT() asm volatile("s_waitcnt lgkmcnt(0)" ::: "memory")

__device__ __forceinline__ float wave_sum(float v) {
#pragma unroll
    for (int o = 1; o < 64; o <<= 1) v += __shfl_xor(v, o);
    return v;
}
__device__ __forceinline__ void tr_item(const float* W, int ldw, int src_col0, int K, int ncols, bf16* WT, int dst_row0, LAS float* scr, int item, int lane) {
    const int nblk = ncols / 32, kb = item / nblk, nb = item % nblk, k0 = 64 * kb, n0 = 32 * nb;
#pragma unroll 8
    for (int i = 0; i < 32; ++i) { const int kk = 2 * i + (lane >> 5); scr[kk * 33 + (lane & 31)] = W[(size_t)(k0 + kk) * ldw + src_col0 + n0 + (lane & 31)]; }
    LDS_WAIT(); asm volatile("" ::: "memory");
    const int c = lane & 7;
#pragma unroll
    for (int j = 0; j < 4; ++j) { const int n = (lane >> 3) + 8 * j; const LAS float* s = scr + (8 * c) * 33 + n;
        v4u o; o.x = cvt_pk_bf16(s[0 * 33], s[1 * 33]); o.y = cvt_pk_bf16(s[2 * 33], s[3 * 33]); o.z = cvt_pk_bf16(s[4 * 33], s[5 * 33]); o.w = cvt_pk_bf16(s[6 * 33], s[7 * 33]);
        *(v4u*)(WT + (size_t)(dst_row0 + n0 + n) * K + k0 + 8 * c) = o; }
    LDS_WAIT(); asm volatile("" ::: "memory");
}
__device__ __forceinline__ void rms_row_to_bf16(const float* xrow, const f32x4 (&g)[4], bf16* orow, int lane) {
    const f32x4* xr = (const f32x4*)xrow + lane;
    f32x4 v[4]; float s = 0.f;
#pragma unroll
    for (int j = 0; j < 4; ++j) { v[j] = xr[64 * j]; s += (v[j].x * v[j].x + v[j].y * v[j].y) + (v[j].z * v[j].z + v[j].w * v[j].w); }
    const float rstd = __builtin_amdgcn_rsqf(wave_sum(s) * (1.f / D) + EPS);
    v2u* o8 = (v2u*)orow + lane;
#pragma unroll
    for (int j = 0; j < 4; ++j) { const f32x4 y = v[j] * rstd * g[j]; v2u w; w.x = cvt_pk_bf16(y.x, y.y); w.y = cvt_pk_bf16(y.z, y.w); o8[64 * j] = w; }
}

struct Ptrs {
    const float *x, *meta, *norm_mix, *w_in, *w_pool_mix, *pool_scale, *w_pool_out, *w_gate_up, *b_gate, *gla_norm, *w_gla_out, *w_out, *norm_ffn, *w_ff1, *w_ff2, *norm_final;
    float* out; unsigned char* ws;
};

__device__ __forceinline__ void p0_prologue(const Ptrs& P, LAS unsigned char* lds, int tid, int G) {
    const int lane = tid & 63, wave = tid >> 6;
    LAS float* scr = (LAS float*)(lds + wave * 16384);
    const int gw = blockIdx.x * NWAVES + wave, NGW = G * NWAVES;
    bf16* WIN = (bf16*)(P.ws + WS_WIN); bf16* WA = (bf16*)(P.ws + WS_WA); bf16* WB = (bf16*)(P.ws + WS_WB); bf16* WO = (bf16*)(P.ws + WS_WO);
    bf16* W1 = (bf16*)(P.ws + WS_W1); bf16* W2 = (bf16*)(P.ws + WS_W2); bf16* U = (bf16*)(P.ws + WS_U);
    constexpr int I_IN0 = 16 * 64, I_GA = 16 * 32, I_GB = 16 * 32, I_B = 8 * 32, I_O = 16 * 32, I_1 = 16 * 128, I_2 = 64 * 32;
    constexpr int NITEMS = I_IN0 + I_GA + I_GB + I_B + I_O + I_1 + I_2;
    for (int it = gw; it < NITEMS; it += NGW) {
        int r = it;
        if (r < I_IN0) { tr_item(P.w_in, W_IN_LD, 0, D, 2048, WIN, 0, scr, r, lane); continue; } r -= I_IN0;
        if (r < I_GA) { tr_item(P.w_in, W_IN_LD, 2064, D, 1024, WIN, 2304, scr, r, lane); continue; } r -= I_GA;
        if (r < I_GB) { tr_item(P.w_in, W_IN_LD, 3088, D, 1024, WIN, 3328, scr, r, lane); continue; } r -= I_GB;
        if (r < I_B) { tr_item(P.w_gla_out, D, 0, 512, 1024, WB, 0, scr, r, lane); continue; } r -= I_B;
        if (r < I_O) { tr_item(P.w_out, D, 0, D, 1024, WO, 0, scr, r, lane); continue; } r -= I_O;
        if (r < I_1) { tr_item(P.w_ff1, FF, 0, D, FF, W1, 0, scr, r, lane); continue; } r -= I_1;
        tr_item(P.w_ff2, D, 0, FF, 1024, W2, 0, scr, r, lane);
    }
    const int gt = blockIdx.x * NTHR + tid, NGT = G * NTHR;
    for (int task = gt; task < 256 * 128; task += NGT) {
        const int j = task & 255, k0 = (task >> 8) * 8; float wg[16];
#pragma unroll
        for (int r = 0; r < 16; ++r) wg[r] = P.w_gate_up[r * 256 + j];
        float o[8];
#pragma unroll
        for (int i = 0; i < 8; ++i) { const f32x4* wr = (const f32x4*)(P.w_in + (size_t)(k0 + i) * W_IN_LD + 2048); float s = 0.f;
#pragma unroll
            for (int q = 0; q < 4; ++q) { const f32x4 w4 = wr[q]; s += w4.x * wg[4 * q] + w4.y * wg[4 * q + 1] + w4.z * wg[4 * q + 2] + w4.w * wg[4 * q + 3]; }
            o[i] = s; }
        v4u w; w.x = cvt_pk_bf16(o[0], o[1]); w.y = cvt_pk_bf16(o[2], o[3]); w.z = cvt_pk_bf16(o[4], o[5]); w.w = cvt_pk_bf16(o[6], o[7]);
        *(v4u*)(WIN + (size_t)(2048 + j) * D + k0) = w;
    }
    for (int task = gt; task < 1024 * 64; task += NGT) {
        const int n = task & 1023, cg8 = task >> 10, c0 = cg8 * 8, g = c0 >> 7, cl0 = c0 & 127; float o[8];
#pragma unroll
        for (int i = 0; i < 8; ++i) o[i] = 0.f;
        const float* wm = P.w_pool_mix + ((size_t)g * 128 + cl0) * 128;
        for (int e = 0; e < 128; ++e) { const float wp = P.w_pool_out[(size_t)(g * 128 + e) * D + n] * P.pool_scale[g * 128 + e];
#pragma unroll
            for (int i = 0; i < 8; ++i) o[i] += wm[i * 128 + e] * wp; }
        v4u w; w.x = cvt_pk_bf16(o[0], o[1]); w.y = cvt_pk_bf16(o[2], o[3]); w.z = cvt_pk_bf16(o[4], o[5]); w.w = cvt_pk_bf16(o[6], o[7]);
        *(v4u*)(WA + (size_t)n * 512 + c0) = w;
    }
    f32x4 g[4];
#pragma unroll
    for (int j = 0; j < 4; ++j) g[j] = ((const f32x4*)P.norm_mix)[lane + 64 * j];
    for (int m = gw; m < T; m += NGW) rms_row_to_bf16(P.x + (size_t)m * D, g, U + (size_t)m * D, lane);
    for (int m = gw; m < 256; m += NGW) {
        bf16* orow = U + (size_t)(T + m) * D;
        if (m >= META_PAD && m < META_PAD + 16) rms_row_to_bf16(P.meta + (size_t)(m - META_PAD) * D, g, orow, lane);
        else { v4u z = {0u, 0u, 0u, 0u}; ((v4u*)orow)[lane] = z; ((v4u*)orow)[lane + 64] = z; }
    }
}

constexpr int RS = 72;
__device__ __forceinline__ bf16x8 ldsv(const LAS bf16* p) { return *(const LAS bf16x8*)p; }
__device__ __forceinline__ void gla_item(LAS unsigned char* lds, int item, const bf16* Qg, const bf16* Kg, const bf16* Vg, const bf16* Rg, const float* LAg, const float* gn, bf16* ON, int tid) {
    const int b = item >> 2, h = item & 3;
    const int w = __builtin_amdgcn_readfirstlane(tid >> 6), lane = tid & 63, fr = lane & 15, fq = lane >> 4;
    LAS bf16* sQp = (LAS bf16*)lds; LAS bf16* sQm = sQp + 64 * RS; LAS bf16* sKm = sQm + 64 * RS; LAS bf16* sKp = sKm + 64 * RS; LAS bf16* sKeT = sKp + 64 * RS;
    LAS bf16* sVT = sKeT + 64 * RS; LAS bf16* sP = sVT + 128 * RS; LAS bf16* sST = sP + 64 * RS; LAS float* sD = (LAS float*)(sST + 128 * RS); LAS float* sSsq = sD + 64;
    const int tt = w & 3, vh = w >> 2;
    f32x4 Sacc[4], gnr[4];
#pragma unroll
    for (int j = 0; j < 4; ++j) { Sacc[j] = (f32x4){0.f, 0.f, 0.f, 0.f}; gnr[j] = *(const f32x4*)(gn + h * 128 + 64 * vh + 16 * j + 4 * fq); }
    v4u q8, k8, v16a, v16b; f32x4 la0, la1;
#ifdef EXP_NO_META
    for (int i = tid; i < 128 * RS / 2; i += NTHR) ((LAS unsigned*)sST)[i] = 0u;
    __syncthreads();
#endif
#define GLA_LOAD(c) do { const size_t row = ((c) == 0 ? (size_t)T : (size_t)b * SEQ + (size_t)((c) - 1) * 64) + lane; \
        q8 = *(const v4u*)(Qg + row * 256 + h * 64 + 8 * w); k8 = *(const v4u*)(Kg + row * 256 + h * 64 + 8 * w); \
        la0 = *(const f32x4*)(LAg + row * 256 + h * 64 + 8 * w); la1 = *(const f32x4*)(LAg + row * 256 + h * 64 + 8 * w + 4); \
        v16a = *(const v4u*)(Vg + row * 512 + h * 128 + 16 * w); v16b = *(const v4u*)(Vg + row * 512 + h * 128 + 16 * w + 8); } while (0)
#ifdef EXP_NO_META
    GLA_LOAD(1);
    for (int c = 1; c <= NCHUNK; ++c) {
#else
    GLA_LOAD(0);
    for (int c = 0; c <= NCHUNK; ++c) {
#endif
        float bc[8] = {la0.x, la0.y, la0.z, la0.w, la1.x, la1.y, la1.z, la1.w};
        if (c == 0 && lane < META_PAD) {
#pragma unroll
            for (int i = 0; i < 8; ++i) bc[i] = 0.f; }
#pragma unroll
        for (int i = 0; i < 8; ++i) {
#pragma unroll
            for (int d = 1; d < 64; d <<= 1) { const float n = __shfl_up(bc[i], d); if (lane >= d) bc[i] += n; } }
        float qf[8] = {bf_lo(q8.x), bf_hi(q8.x), bf_lo(q8.y), bf_hi(q8.y), bf_lo(q8.z), bf_hi(q8.z), bf_lo(q8.w), bf_hi(q8.w)};
        float kf[8] = {bf_lo(k8.x), bf_hi(k8.x), bf_lo(k8.y), bf_hi(k8.y), bf_lo(k8.z), bf_hi(k8.z), bf_lo(k8.w), bf_hi(k8.w)};
        float qp[8], qm[8], km[8], kp[8], ke[8], dd[8];
#pragma unroll
        for (int i = 0; i < 8; ++i) { const float be = __shfl(bc[i], 63); const float eb = __expf(bc[i]), emb = __expf(-bc[i]), ek = __expf(be - bc[i]);
            qp[i] = qf[i] * eb; qm[i] = qf[i] * emb; km[i] = kf[i] * emb; kp[i] = kf[i] * eb; ke[i] = kf[i] * ek; dd[i] = __expf(be); }
        {
            v4u o;
            o.x = cvt_pk_bf16(qp[0], qp[1]); o.y = cvt_pk_bf16(qp[2], qp[3]); o.z = cvt_pk_bf16(qp[4], qp[5]); o.w = cvt_pk_bf16(qp[6], qp[7]); *(LAS v4u*)(sQp + lane * RS + 8 * w) = o;
            o.x = cvt_pk_bf16(qm[0], qm[1]); o.y = cvt_pk_bf16(qm[2], qm[3]); o.z = cvt_pk_bf16(qm[4], qm[5]); o.w = cvt_pk_bf16(qm[6], qm[7]); *(LAS v4u*)(sQm + lane * RS + 8 * w) = o;
            o.x = cvt_pk_bf16(km[0], km[1]); o.y = cvt_pk_bf16(km[2], km[3]); o.z = cvt_pk_bf16(km[4], km[5]); o.w = cvt_pk_bf16(km[6], km[7]); *(LAS v4u*)(sKm + lane * RS + 8 * w) = o;
            o.x = cvt_pk_bf16(kp[0], kp[1]); o.y = cvt_pk_bf16(kp[2], kp[3]); o.z = cvt_pk_bf16(kp[4], kp[5]); o.w = cvt_pk_bf16(kp[6], kp[7]); *(LAS v4u*)(sKp + lane * RS + 8 * w) = o;
        }
#pragma unroll
        for (int i = 0; i < 8; i += 2) { const unsigned pk = cvt_pk_bf16(ke[i], ke[i + 1]); sKeT[(8 * w + i) * RS + lane] = (bf16)(pk & 0xffffu); sKeT[(8 * w + i + 1) * RS + lane] = (bf16)(pk >> 16); }
        {
            const unsigned vv[8] = {v16a.x, v16a.y, v16a.z, v16a.w, v16b.x, v16b.y, v16b.z, v16b.w};
#pragma unroll
            for (int i = 0; i < 8; ++i) { sVT[(16 * w + 2 * i) * RS + lane] = (bf16)(vv[i] & 0xffffu); sVT[(16 * w + 2 * i + 1) * RS + lane] = (bf16)(vv[i] >> 16); }
        }
        if (lane == 0) {
#pragma unroll
            for (int i = 0; i < 8; ++i) sD[8 * w + i] = dd[i]; }
        const int cn = (c < NCHUNK) ? c + 1 : c;
        GLA_LOAD(cn);
        v2u rr[4];
        const size_t orow = (size_t)b * SEQ + (size_t)(c > 0 ? c - 1 : 0) * 64 + 16 * tt + fr;
#pragma unroll
        for (int j = 0; j < 4; ++j) rr[j] = *(const v2u*)(Rg + orow * 512 + h * 128 + 64 * vh + 16 * j + 4 * fq);
        __syncthreads();
        f32x4 oacc[4];
#pragma unroll
        for (int j = 0; j < 4; ++j) oacc[j] = (f32x4){0.f, 0.f, 0.f, 0.f};
        if (c > 0) {
            const int st_t = w >> 1;
#pragma unroll
            for (int s2 = 0; s2 < 2; ++s2) { const int st = 2 * (w & 1) + s2; f32x4 a1 = {0.f, 0.f, 0.f, 0.f}, a2 = {0.f, 0.f, 0.f, 0.f};
                if (st <= st_t) {
#pragma unroll
                    for (int kk = 0; kk < 2; ++kk) a1 = __builtin_amdgcn_mfma_f32_16x16x32_bf16(ldsv(sKm + (16 * st + fr) * RS + 32 * kk + 8 * fq), ldsv(sQp + (16 * st_t + fr) * RS + 32 * kk + 8 * fq), a1, 0, 0, 0); }
                if (st >= st_t) {
#pragma unroll
                    for (int kk = 0; kk < 2; ++kk) a2 = __builtin_amdgcn_mfma_f32_16x16x32_bf16(ldsv(sKp + (16 * st + fr) * RS + 32 * kk + 8 * fq), ldsv(sQm + (16 * st_t + fr) * RS + 32 * kk + 8 * fq), a2, 0, 0, 0); }
                const int t = 16 * st_t + fr, s0 = 16 * st + 4 * fq; float p[4];
#pragma unroll
                for (int i = 0; i < 4; ++i) p[i] = (s0 + i <= t) ? a1[i] : a2[i];
                v2u o; o.x = cvt_pk_bf16(p[0], p[1]); o.y = cvt_pk_bf16(p[2], p[3]); *(LAS v2u*)(sP + t * RS + s0) = o; }
#pragma unroll
            for (int j = 0; j < 4; ++j)
#pragma unroll
                for (int kk = 0; kk < 2; ++kk) oacc[j] = __builtin_amdgcn_mfma_f32_16x16x32_bf16(ldsv(sST + (16 * (4 * vh + j) + fr) * RS + 32 * kk + 8 * fq), ldsv(sQp + (16 * tt + fr) * RS + 32 * kk + 8 * fq), oacc[j], 0, 0, 0);
        }
        __syncthreads();
        if (c > 0) {
#pragma unroll
            for (int j = 0; j < 4; ++j)
#pragma unroll
                for (int kk = 0; kk < 2; ++kk) oacc[j] = __builtin_amdgcn_mfma_f32_16x16x32_bf16(ldsv(sVT + (16 * (4 * vh + j) + fr) * RS + 32 * kk + 8 * fq), ldsv(sP + (16 * tt + fr) * RS + 32 * kk + 8 * fq), oacc[j], 0, 0, 0);
        }
        {
            const f32x4 dv = *(const LAS f32x4*)(sD + 16 * tt + 4 * fq);
#pragma unroll
            for (int j = 0; j < 4; ++j) { Sacc[j] = Sacc[j] * dv;
#pragma unroll
                for (int kk = 0; kk < 2; ++kk) Sacc[j] = __builtin_amdgcn_mfma_f32_16x16x32_bf16(ldsv(sKeT + (16 * tt + fr) * RS + 32 * kk + 8 * fq), ldsv(sVT + (16 * (4 * vh + j) + fr) * RS + 32 * kk + 8 * fq), Sacc[j], 0, 0, 0);
                v2u o; o.x = cvt_pk_bf16(Sacc[j][0], Sacc[j][1]); o.y = cvt_pk_bf16(Sacc[j][2], Sacc[j][3]); *(LAS v2u*)(sST + (16 * (4 * vh + j) + fr) * RS + 16 * tt + 4 * fq) = o; }
        }
        float ss = 0.f;
#pragma unroll
        for (int j = 0; j < 4; ++j) ss += (oacc[j][0] * oacc[j][0] + oacc[j][1] * oacc[j][1]) + (oacc[j][2] * oacc[j][2] + oacc[j][3] * oacc[j][3]);
        ss += __shfl_xor(ss, 16); ss += __shfl_xor(ss, 32);
        if (fq == 0) sSsq[(16 * tt + fr) * 2 + vh] = ss;
        __syncthreads();
        if (c > 0) {
            const float tot = sSsq[(16 * tt + fr) * 2] + sSsq[(16 * tt + fr) * 2 + 1];
            const float rstd = __builtin_amdgcn_rsqf(tot * (1.0f / 128.0f) + EPS);
#pragma unroll
            for (int j = 0; j < 4; ++j) { const f32x4 rv = {bf_lo(rr[j].x), bf_hi(rr[j].x), bf_lo(rr[j].y), bf_hi(rr[j].y)}; const f32x4 y = oacc[j] * rstd * gnr[j] * rv;
                v2u o; o.x = cvt_pk_bf16(y[0], y[1]); o.y = cvt_pk_bf16(y[2], y[3]); *(v2u*)(ON + orow * 512 + h * 128 + 64 * vh + 16 * j + 4 * fq) = o; }
        }
    }
#undef GLA_LOAD
    __syncthreads();
}
__device__ __forceinline__ void pool_task(int task, const bf16* Ab, bf16* PA, int tid) {
    const int wave = tid >> 6, lane = tid & 63, b = task >> 3, i0 = (task & 7) * 256 + wave * 32;
    const int wd = 2 << (lane >> 4); const float inv = 1.0f / (float)wd;
    float sum[8];
#pragma unroll
    for (int e = 0; e < 8; ++e) sum[e] = 0.f;
#define AROW(i) ((i) >= 0 ? (size_t)b * SEQ + (size_t)(i) : (size_t)(T + 64 + (i)))
#define UNPK(w8, f) { f[0] = bf_lo(w8.x); f[1] = bf_hi(w8.x); f[2] = bf_lo(w8.y); f[3] = bf_hi(w8.y); f[4] = bf_lo(w8.z); f[5] = bf_hi(w8.z); f[6] = bf_lo(w8.w); f[7] = bf_hi(w8.w); }
    for (int d = 1; d < 16; ++d) if (d < wd) { const v4u w8 = *(const v4u*)(Ab + AROW(i0 - d) * 512 + 8 * lane); float f[8]; UNPK(w8, f);
#pragma unroll
        for (int e = 0; e < 8; ++e) sum[e] += f[e]; }
#pragma unroll 4
    for (int i = i0; i < i0 + 32; ++i) {
        const v4u c8 = *(const v4u*)(Ab + AROW(i) * 512 + 8 * lane); const v4u o8 = *(const v4u*)(Ab + AROW(i - wd + 1) * 512 + 8 * lane);
        float cf[8], of[8], y[8]; UNPK(c8, cf); UNPK(o8, of);
#pragma unroll
        for (int e = 0; e < 8; ++e) { sum[e] += cf[e]; y[e] = sum[e] * inv - cf[e]; sum[e] -= of[e]; }
        v4u o; o.x = cvt_pk_bf16(y[0], y[1]); o.y = cvt_pk_bf16(y[2], y[3]); o.z = cvt_pk_bf16(y[4], y[5]); o.w = cvt_pk_bf16(y[6], y[7]);
        *(v4u*)(PA + ((size_t)b * SEQ + i) * 512 + 8 * lane) = o;
    }
#undef AROW
#undef UNPK
}

struct Args { Ptrs p; int ph_lo, ph_hi, coop, pad; };
__global__ void __launch_bounds__(NTHR, 2) hybrid_fwd(Args args) {
    extern __shared__ __attribute__((aligned(16))) unsigned char lds_raw[];
    cg::grid_group grid = cg::this_grid();
    LAS unsigned char* lds = (LAS unsigned char*)lds_raw;
    const Ptrs& P = args.p;
    const int tid = threadIdx.x, G = gridDim.x, lo = args.ph_lo, hi = args.ph_hi;
    unsigned char* ws = P.ws;
    bf16* WIN = (bf16*)(ws + WS_WIN); bf16* WA = (bf16*)(ws + WS_WA); bf16* WB = (bf16*)(ws + WS_WB); bf16* WO = (bf16*)(ws + WS_WO); bf16* W1 = (bf16*)(ws + WS_W1); bf16* W2 = (bf16*)(ws + WS_W2);
    float* SSQ = (float*)(ws + WS_SSQ); bf16* U = (bf16*)(ws + WS_U); bf16* MB = U;
    bf16* Ab = (bf16*)(ws + WS_A); bf16* Qb = (bf16*)(ws + WS_Q); bf16* Kb = (bf16*)(ws + WS_K); bf16* Vb = (bf16*)(ws + WS_V); bf16* Rb = (bf16*)(ws + WS_R);
    float* LAb = (float*)(ws + WS_LA); bf16* GAb = (bf16*)(ws + WS_GA); bf16* GBb = (bf16*)(ws + WS_GB);
    bf16* PA = (bf16*)(ws + WS_PA); bf16* ON = (bf16*)(ws + WS_ON); bf16* U2 = (bf16*)(ws + WS_U2); bf16* HD = (bf16*)(ws + WS_HD);
#define IN(k) (lo <= (k) && (k) < hi)
#define SEAM(k) do { if (IN(k) && IN((k) + 1)) grid.sync(); } while (0)
    if (IN(0)) { p0_prologue(P, lds, tid, G); __syncthreads(); }
    SEAM(0);
    if (IN(1)) {
        pg8::Gemm g{U, WIN, TP, NZ, D}; pg8::StaticOrder S; S.init(TP, NZ, G, (int)blockIdx.x);
        pg8::EpiZ E{Ab, Qb, Kb, Vb, Rb, LAb, GAb, GBb, P.b_gate};
        pg8::gemm_phase<pg8::EpiZ, pg8::StaticOrder, PG8_ALIGN, PG8_SP2>(lds, g, S, E);
    }
    SEAM(1);
    if (IN(2)) {
#ifdef EXP_SKIP_GLA
        { v4u z = {0u,0u,0u,0u}; for (size_t i = (size_t)blockIdx.x * NTHR + tid; i < (size_t)T * 512 / 8; i += (size_t)G * NTHR) ((v4u*)ON)[i] = z; }
#else
        for (int item = blockIdx.x; item < BATCH * 4; item += G) gla_item(lds, item, Qb, Kb, Vb, Rb, LAb, P.gla_norm, ON, tid);
#endif
        if (G > 128) { for (int task = (int)blockIdx.x - 128; task >= 0 && task < 256; task += G - 128) pool_task(task, Ab, PA, tid); }
        else { for (int task = blockIdx.x; task < 256; task += G) pool_task(task, Ab, PA, tid); }
    }
    SEAM(2);
    if (IN(3)) {
        pg8::Gemm g{PA, WA, T, D, 512}; pg8::StaticOrder S; S.init(T, D, G, (int)blockIdx.x);
        pg8::EpiGate<false> E{GAb, MB};
        pg8::gemm_phase<pg8::EpiGate<false>, pg8::StaticOrder, PG8_ALIGN, PG8_SP2>(lds, g, S, E);
    }
    SEAM(3);
    if (IN(4)) {
        pg8::Gemm g{ON, WB, T, D, 512}; pg8::StaticOrder S; S.init(T, D, G, (int)blockIdx.x);
        pg8::EpiGate<true> E{GBb, MB};
        pg8::gemm_phase<pg8::EpiGate<true>, pg8::StaticOrder, PG8_ALIGN, PG8_SP2>(lds, g, S, E);
    }
    SEAM(4);
    if (IN(5)) {
        pg8::Gemm g{MB, WO, T, D, D}; pg8::StaticOrder S; S.init(T, D, G, (int)blockIdx.x);
        pg8::EpiOut E{P.x, P.out, U2, P.norm_ffn, SSQ};
        pg8::gemm_phase<pg8::EpiOut, pg8::StaticOrder, PG8_ALIGN, PG8_SP2>(lds, g, S, E);
    }
    SEAM(5);
    if (IN(6)) {
        pg8::Gemm g{U2, W1, T, FF, D}; pg8::StaticOrder S; S.init(T, FF, G, (int)blockIdx.x);
        pg8::EpiFF1 E{SSQ, HD};
        pg8::gemm_phase<pg8::EpiFF1, pg8::StaticOrder, PG8_ALIGN, PG8_SP2>(lds, g, S, E);
    }
    SEAM(6);
    if (IN(7)) {
        pg8::Gemm g{HD, W2, T, D, FF}; pg8::StaticOrder S; S.init(T, D, G, (int)blockIdx.x);
        pg8::EpiFF2 E{P.out};
        pg8::gemm_phase<pg8::EpiFF2, pg8::StaticOrder, PG8_ALIGN, PG8_SP2>(lds, g, S, E);
    }
    SEAM(7);
    if (IN(8)) {
        const int lane = tid & 63, gw = blockIdx.x * NWAVES + (tid >> 6), NGW = G * NWAVES;
        f32x4 g[4];
#pragma unroll
        for (int j = 0; j < 4; ++j) g[j] = ((const f32x4*)P.norm_final)[lane + 64 * j];
        for (int m = gw; m < T; m += NGW) {
            f32x4* xr = (f32x4*)(P.out + (size_t)m * D) + lane; f32x4 v[4]; float s = 0.f;
#pragma unroll
            for (int j = 0; j < 4; ++j) { v[j] = xr[64 * j]; s += (v[j].x * v[j].x + v[j].y * v[j].y) + (v[j].z * v[j].z + v[j].w * v[j].w); }
            const float rstd = __builtin_amdgcn_rsqf(wave_sum(s) * (1.f / D) + EPS);
#pragma unroll
            for (int j = 0; j < 4; ++j) xr[64 * j] = v[j] * rstd * g[j];
        }
    }
#undef IN
#undef SEAM
}

constexpr int N_PHASES = 9;
extern "C" void kernel_launch(void* const* d_in, const int* in_sizes, int n_in, void* d_out, int out_size, void* d_ws, size_t ws_size, hipStream_t stream) {
    static int grid = 0;
    if (grid == 0) {
        if (n_in != 16 || in_sizes[0] != T * D || out_size != T * D || ws_size < WS_END) { fprintf(stderr, "kernel_launch: unexpected shapes (n_in %d in0 %d out %d ws %zu)\n", n_in, n_in > 0 ? in_sizes[0] : -1, out_size, ws_size); grid = -1; return; }
        int dev = 0, cus = 0, per_cu = 0;
        hipGetDevice(&dev); hipDeviceGetAttribute(&cus, hipDeviceAttributeMultiprocessorCount, dev);
        if (hipFuncSetAttribute((const void*)hybrid_fwd, hipFuncAttributeMaxDynamicSharedMemorySize, LDS_BYTES) != hipSuccess) { fprintf(stderr, "kernel_launch: hipFuncSetAttribute failed\n"); grid = -1; return; }
        if (hipOccupancyMaxActiveBlocksPerMultiprocessor(&per_cu, (const void*)hybrid_fwd, NTHR, LDS_BYTES) != hipSuccess || per_cu < 1) { fprintf(stderr, "kernel_launch: occupancy query says %d\n", per_cu); per_cu = 1; }
        (void)hipGetLastError();
        grid = cus * 1;
        if (grid <= 0) grid = 256;
    }
    if (grid < 0) return;
    Args a{};
    Ptrs& p = a.p;
    p.x = (const float*)d_in[0]; p.meta = (const float*)d_in[1]; p.norm_mix = (const float*)d_in[2]; p.w_in = (const float*)d_in[3]; p.w_pool_mix = (const float*)d_in[4];
    p.pool_scale = (const float*)d_in[5]; p.w_pool_out = (const float*)d_in[6]; p.w_gate_up = (const float*)d_in[7]; p.b_gate = (const float*)d_in[8]; p.gla_norm = (const float*)d_in[9];
    p.w_gla_out = (const float*)d_in[10]; p.w_out = (const float*)d_in[11]; p.norm_ffn = (const float*)d_in[12]; p.w_ff1 = (const float*)d_in[13]; p.w_ff2 = (const float*)d_in[14];
    p.norm_final = (const float*)d_in[15]; p.out = (float*)d_out; p.ws = (unsigned char*)d_ws;
#if MK_N_LAUNCHES == 1
    a.ph_lo = 0; a.ph_hi = N_PHASES; a.coop = 1;
    void* kargs[] = {&a};
    hipError_t e = hipLaunchCooperativeKernel((const void*)hybrid_fwd, dim3(grid), dim3(NTHR), kargs, LDS_BYTES, stream);
    if (e != hipSuccess) fprintf(stderr, "kernel_launch: cooperative launch failed: %s (grid %d)\n", hipGetErrorString(e), grid);
#else
    for (int ph = 0; ph < N_PHASES; ++ph) { a.ph_lo = ph; a.ph_hi = ph + 1; a.coop = 0;
        hipLaunchKernelGGL(hybrid_fwd, dim3(grid), dim3(NTHR), LDS_BYTES, stream, a); }
#endif
}
```

```cpp
#include <hip/hip_runtime.h>
#include <hip/hip_cooperative_groups.h>
#include <cstdio>
#include <cstdint>
namespace cg = cooperative_groups;

#ifndef PROBE_DUP
#define PROBE_DUP 0
#endif
#ifndef MK_N_LAUNCHES
#define MK_N_LAUNCHES 1
#endif

namespace pg8 {
#define PG8_LAS __attribute__((address_space(3)))
typedef unsigned short bf16_t;
typedef short bf16x8 __attribute__((ext_vector_type(8)));
typedef float f32x4 __attribute__((ext_vector_type(4)));
typedef unsigned u32x4 __attribute__((ext_vector_type(4)));
constexpr int BM = 256, BK = 64, HALF = 128, HTB = HALF * BK * 2  , STAGE_BYTES = 8 * HTB, NXCD = 8, WGM = 8;

__host__ __device__ __forceinline__ int lds_byte(int r, int c) { const int st = (r >> 4) * 2 + (c >> 5), rr = r & 15, cc = c & 31, ob = rr * 64 + cc * 2; return st * 1024 + (ob ^ (((ob >> 9) & 1) << 5)); }
__host__ __device__ __forceinline__ void stage_rc(int b, int& R, int& C) { const int st = b / 1024, sb = b % 1024, swz = sb ^ (((sb >> 9) & 1) << 5); R = (st >> 1) * 16 + swz / 64; C = (st & 1) * 32 + (swz % 64) / 2; }
__host__ __device__ __forceinline__ int perm32(int rho) { const int n = rho >> 4, i = rho & 15; return 8 * (i >> 2) + 4 * n + (i & 3); }

struct Unit { int pm, pn; };
struct Gemm { const bf16_t* A; const bf16_t* Bt; int M, N, K; };

struct StaticOrder {
    int nM, nN, nwg, G, c;
    __host__ __device__ void init(int M, int N, int G_, int c_) { nM = M / BM; nN = N / BM; nwg = nM * nN; G = G_; c = c_; }
    __host__ __device__ bool next(int i, Unit& u) const {
        const long L = (long)i * G + c; if (L >= nwg) return false;
        int wgid = (int)L; { const int q = nwg / NXCD, r = nwg % NXCD, xcd = wgid % NXCD, off = wgid / NXCD; wgid = (xcd < r ? xcd * (q + 1) : r * (q + 1) + (xcd - r) * q) + off; }
        const int nig = WGM * nN, gid = wgid / nig, fm = gid * WGM, gsz = (nM - fm) < WGM ? (nM - fm) : WGM;
        u.pm = fm + ((wgid % nig) % gsz); u.pn = (wgid % nig) / gsz; return true;
    }
    __device__ __forceinline__ void a_ready(const Unit&) const {}
    __device__ __forceinline__ void done(const Unit&) const {}
};

typedef float f32x2_t __attribute__((ext_vector_type(2))); typedef __bf16 bf16x2_t __attribute__((ext_vector_type(2)));
__device__ __forceinline__ unsigned cvt_pk_bf16(float lo, float hi) { f32x2_t v = {lo, hi}; bf16x2_t b = __builtin_convertvector(v, bf16x2_t); return __builtin_bit_cast(unsigned, b); }
typedef unsigned u32x2 __attribute__((ext_vector_type(2)));
__device__ __forceinline__ float bf_lo(unsigned w) { return __uint_as_float(w << 16); }
__device__ __forceinline__ float bf_hi(unsigned w) { return __uint_as_float(w & 0xffff0000u); }
__device__ __forceinline__ float sigm(float v) { return __builtin_amdgcn_rcpf(1.0f + __expf(-v)); }
__device__ __forceinline__ float logsig(float v) { return fminf(v, 0.f) - __logf(1.0f + __expf(-fabsf(v))); }
__device__ __forceinline__ u32x4 pack8(f32x4 v0, f32x4 v1) { u32x4 w; w.x = cvt_pk_bf16(v0[0], v0[1]); w.y = cvt_pk_bf16(v0[2], v0[3]); w.z = cvt_pk_bf16(v1[0], v1[1]); w.w = cvt_pk_bf16(v1[2], v1[3]); return w; }

struct EpiZ {
    static constexpr bool PERM = true, AFTER_DRAIN = false;
    bf16_t* Ab; bf16_t* Qb; bf16_t* Kb; bf16_t* Vb; bf16_t* Rb; float* LAb; bf16_t* GAb; bf16_t* GBb; const float* bgate;
    template <int MODE> __device__ __forceinline__ void put(const f32x4 (&acc)[2][2][4][2], bf16_t* base, int ldc, int row0, int col0) const {
#pragma unroll
        for (int ai = 0; ai < 2; ++ai)
#pragma unroll
            for (int m = 0; m < 4; ++m) { bf16_t* rowp = base + (size_t)(row0 + ai * HALF + m * 16) * ldc + col0;
#pragma unroll
                for (int bj = 0; bj < 2; ++bj) { f32x4 v0 = acc[ai][bj][m][0], v1 = acc[ai][bj][m][1];
                    if (MODE == 1) { v0 = v0 * 0.125f; v1 = v1 * 0.125f; }
                    if (MODE == 2) {
#pragma unroll
                        for (int e = 0; e < 4; ++e) { v0[e] = v0[e] * sigm(v0[e]); v1[e] = v1[e] * sigm(v1[e]); } }
                    if (MODE == 3) {
#pragma unroll
                        for (int e = 0; e < 4; ++e) { v0[e] = sigm(v0[e]); v1[e] = sigm(v1[e]); } }
                    *(u32x4*)(rowp + bj * HALF) = pack8(v0, v1); } }
    }
    __device__ __forceinline__ void operator()(const f32x4 (&acc)[2][2][4][2], const Unit& u, int wr, int wc, int fr, int fq) const {
        const int pn = u.pn, row0 = u.pm * BM + wr * 64 + fr, cl = wc * 32 + 8 * fq;
        if (pn < 2) put<0>(acc, Ab, 512, row0, pn * 256 + cl);
        else if (pn == 2) put<1>(acc, Qb, 256, row0, cl);
        else if (pn == 3) put<0>(acc, Kb, 256, row0, cl);
        else if (pn < 6) put<0>(acc, Vb, 512, row0, (pn - 4) * 256 + cl);
        else if (pn < 8) put<2>(acc, Rb, 512, row0, (pn - 6) * 256 + cl);
        else if (pn == 8) {
#pragma unroll
            for (int bj = 0; bj < 2; ++bj) { const f32x4 b0 = *(const f32x4*)(bgate + cl + bj * HALF), b1 = *(const f32x4*)(bgate + cl + bj * HALF + 4);
#pragma unroll
                for (int ai = 0; ai < 2; ++ai)
#pragma unroll
                    for (int m = 0; m < 4; ++m) { float* p = LAb + (size_t)(row0 + ai * HALF + m * 16) * 256 + cl + bj * HALF;
                        f32x4 v0 = acc[ai][bj][m][0] + b0, v1 = acc[ai][bj][m][1] + b1;
#pragma unroll
                        for (int e = 0; e < 4; ++e) { v0[e] = logsig(v0[e]) * 0.0625f; v1[e] = logsig(v1[e]) * 0.0625f; }
                        *(f32x4*)p = v0; *(f32x4*)(p + 4) = v1; } }
        }
        else if (pn < 13) put<3>(acc, GAb, 1024, row0, (pn - 9) * 256 + cl);
        else put<3>(acc, GBb, 1024, row0, (pn - 13) * 256 + cl);
    }
};
template <bool ADD> struct EpiGate {
    static constexpr bool PERM = true, AFTER_DRAIN = false;
    const bf16_t* G; bf16_t* O;
    __device__ __forceinline__ void operator()(const f32x4 (&acc)[2][2][4][2], const Unit& u, int wr, int wc, int fr, int fq) const {
        const int row0 = u.pm * BM + wr * 64 + fr, col0 = u.pn * BM + wc * 32 + 8 * fq;
        if (!ADD) {
            u32x4 g[2][4][2];
#pragma unroll
            for (int ai = 0; ai < 2; ++ai)
#pragma unroll
                for (int m = 0; m < 4; ++m)
#pragma unroll
                    for (int bj = 0; bj < 2; ++bj) g[ai][m][bj] = *(const u32x4*)(G + (size_t)(row0 + ai * HALF + m * 16) * 1024 + col0 + bj * HALF);
#pragma unroll
            for (int ai = 0; ai < 2; ++ai)
#pragma unroll
                for (int m = 0; m < 4; ++m)
#pragma unroll
                    for (int bj = 0; bj < 2; ++bj) { const u32x4 gg = g[ai][m][bj]; f32x4 v0 = acc[ai][bj][m][0], v1 = acc[ai][bj][m][1];
                        v0 = v0 * (f32x4){bf_lo(gg.x), bf_hi(gg.x), bf_lo(gg.y), bf_hi(gg.y)}; v1 = v1 * (f32x4){bf_lo(gg.z), bf_hi(gg.z), bf_lo(gg.w), bf_hi(gg.w)};
                        *(u32x4*)(O + (size_t)(row0 + ai * HALF + m * 16) * 1024 + col0 + bj * HALF) = pack8(v0, v1); }
        } else {
#pragma unroll
            for (int ai = 0; ai < 2; ++ai) {
                u32x4 g[4][2], t[4][2];
#pragma unroll
                for (int m = 0; m < 4; ++m)
#pragma unroll
                    for (int bj = 0; bj < 2; ++bj) { const size_t ro = (size_t)(row0 + ai * HALF + m * 16) * 1024 + col0 + bj * HALF; g[m][bj] = *(const u32x4*)(G + ro); t[m][bj] = *(const u32x4*)(O + ro); }
#pragma unroll
                for (int m = 0; m < 4; ++m)
#pragma unroll
                    for (int bj = 0; bj < 2; ++bj) { const u32x4 gg = g[m][bj], tt = t[m][bj]; f32x4 v0 = acc[ai][bj][m][0], v1 = acc[ai][bj][m][1];
                        v0 = v0 * (f32x4){bf_lo(gg.x), bf_hi(gg.x), bf_lo(gg.y), bf_hi(gg.y)} + (f32x4){bf_lo(tt.x), bf_hi(tt.x), bf_lo(tt.y), bf_hi(tt.y)};
                        v1 = v1 * (f32x4){bf_lo(gg.z), bf_hi(gg.z), bf_lo(gg.w), bf_hi(gg.w)} + (f32x4){bf_lo(tt.z), bf_hi(tt.z), bf_lo(tt.w), bf_hi(tt.w)};
                        *(u32x4*)(O + (size_t)(row0 + ai * HALF + m * 16) * 1024 + col0 + bj * HALF) = pack8(v0, v1); }
            }
        }
    }
};
struct EpiOut {
    static constexpr bool PERM = true, AFTER_DRAIN = false;
    const float* X; float* H; bf16_t* U2; const float* g; float* ssq;
    __device__ __forceinline__ void operator()(const f32x4 (&acc)[2][2][4][2], const Unit& u, int wr, int wc, int fr, int fq) const {
        const int row0 = u.pm * BM + wr * 64 + fr, col0 = u.pn * BM + wc * 32 + 8 * fq;
        f32x4 gv[2][2];
#pragma unroll
        for (int bj = 0; bj < 2; ++bj)
#pragma unroll
            for (int n = 0; n < 2; ++n) gv[bj][n] = *(const f32x4*)(g + col0 + bj * HALF + 4 * n);
#pragma unroll
        for (int ai = 0; ai < 2; ++ai) {
            f32x4 xv[4][2][2];
#pragma unroll
            for (int m = 0; m < 4; ++m)
#pragma unroll
                for (int bj = 0; bj < 2; ++bj) { const size_t ro = (size_t)(row0 + ai * HALF + m * 16) * 1024 + col0 + bj * HALF; xv[m][bj][0] = *(const f32x4*)(X + ro); xv[m][bj][1] = *(const f32x4*)(X + ro + 4); }
#pragma unroll
            for (int m = 0; m < 4; ++m) { const int row = row0 + ai * HALF + m * 16; const size_t ro = (size_t)row * 1024 + col0; float s = 0.f;
#pragma unroll
                for (int bj = 0; bj < 2; ++bj) { const f32x4 h0 = xv[m][bj][0] + acc[ai][bj][m][0], h1 = xv[m][bj][1] + acc[ai][bj][m][1];
                    *(f32x4*)(H + ro + bj * HALF) = h0; *(f32x4*)(H + ro + bj * HALF + 4) = h1;
                    s += (h0[0] * h0[0] + h0[1] * h0[1]) + (h0[2] * h0[2] + h0[3] * h0[3]) + (h1[0] * h1[0] + h1[1] * h1[1]) + (h1[2] * h1[2] + h1[3] * h1[3]);
                    *(u32x4*)(U2 + ro + bj * HALF) = pack8(h0 * gv[bj][0], h1 * gv[bj][1]); }
                s += __shfl_xor(s, 16); s += __shfl_xor(s, 32);
                if (fq == 0) ssq[(size_t)row * 16 + u.pn * 4 + wc] = s; }
        }
    }
};
struct EpiFF1 {
    static constexpr bool PERM = true, AFTER_DRAIN = false;
    const float* ssq; bf16_t* Hd; int skip;
    __device__ __forceinline__ void operator()(const f32x4 (&acc)[2][2][4][2], const Unit& u, int wr, int wc, int fr, int fq) const {
        if (skip) { f32x4 t = {0.f, 0.f, 0.f, 0.f};
#pragma unroll
            for (int ai = 0; ai < 2; ++ai)
#pragma unroll
                for (int bj = 0; bj < 2; ++bj)
#pragma unroll
                    for (int m = 0; m < 4; ++m) t = t + acc[ai][bj][m][0] + acc[ai][bj][m][1];
            if (t[0] + t[1] + t[2] + t[3] == 123.456f) Hd[0] = 0; return; }
        const int row0 = u.pm * BM + wr * 64 + fr, col0 = u.pn * BM + wc * 32 + 8 * fq;
        f32x4 pv[2][4];
#pragma unroll
        for (int ai = 0; ai < 2; ++ai)
#pragma unroll
            for (int m = 0; m < 4; ++m) pv[ai][m] = *(const f32x4*)(ssq + (size_t)(row0 + ai * HALF + m * 16) * 16 + 4 * fq);
#pragma unroll
        for (int ai = 0; ai < 2; ++ai)
#pragma unroll
            for (int m = 0; m < 4; ++m) { const int row = row0 + ai * HALF + m * 16;
                const f32x4 p = pv[ai][m]; float s = (p[0] + p[1]) + (p[2] + p[3]);
                s += __shfl_xor(s, 16); s += __shfl_xor(s, 32);
                const float rstd = __builtin_amdgcn_rsqf(s * (1.0f / 1024.0f) + 1e-6f);
#pragma unroll
                for (int bj = 0; bj < 2; ++bj) { f32x4 v0 = acc[ai][bj][m][0] * rstd, v1 = acc[ai][bj][m][1] * rstd;
#pragma unroll
                    for (int e = 0; e < 4; ++e) { const float a = fmaxf(v0[e], 0.f), b = fmaxf(v1[e], 0.f); v0[e] = a * a; v1[e] = b * b; }
                    *(u32x4*)(Hd + (size_t)row * 4096 + col0 + bj * HALF) = pack8(v0, v1); } }
    }
};
struct EpiFF2 {
    static constexpr bool PERM = true, AFTER_DRAIN = false;
    float* H;
    __device__ __forceinline__ void operator()(const f32x4 (&acc)[2][2][4][2], const Unit& u, int wr, int wc, int fr, int fq) const {
        const int row0 = u.pm * BM + wr * 64 + fr, col0 = u.pn * BM + wc * 32 + 8 * fq;
#pragma unroll
        for (int ai = 0; ai < 2; ++ai) {
            f32x4 xv[4][2][2];
#pragma unroll
            for (int m = 0; m < 4; ++m)
#pragma unroll
                for (int bj = 0; bj < 2; ++bj) { const float* p = H + (size_t)(row0 + ai * HALF + m * 16) * 1024 + col0 + bj * HALF; xv[m][bj][0] = *(const f32x4*)p; xv[m][bj][1] = *(const f32x4*)(p + 4); }
#pragma unroll
            for (int m = 0; m < 4; ++m)
#pragma unroll
                for (int bj = 0; bj < 2; ++bj) { float* p = H + (size_t)(row0 + ai * HALF + m * 16) * 1024 + col0 + bj * HALF;
                    *(f32x4*)p = xv[m][bj][0] + acc[ai][bj][m][0]; *(f32x4*)(p + 4) = xv[m][bj][1] + acc[ai][bj][m][1]; }
        }
    }
};

template <class Epi, class Sched, bool ALIGN_EPI = false, bool SP2 = false>
__device__ __forceinline__ void gemm_phase(PG8_LAS unsigned char* lds, const Gemm g, const Sched& S, const Epi& E) {
    const int tid = threadIdx.x, wid = __builtin_amdgcn_readfirstlane(tid >> 6), lane = tid & 63, wr = wid >> 2, wc = wid & 3, fr = lane & 15, fq = lane >> 4;
    const int K = g.K, nt = K / BK;
    unsigned voffA[2], voffB[2];
#pragma unroll
    for (int i = 0; i < 2; ++i) { int R, C; stage_rc(tid * 16 + i * 8192, R, C); const int Rb = Epi::PERM ? ((R & ~31) + perm32(R & 31)) : R;
        voffA[i] = (unsigned)(R * K + C) * 2u; voffB[i] = (unsigned)(Rb * K + C) * 2u; }
    const size_t kstep = (size_t)(BK * 2);
    const size_t hstep = (size_t)HALF * K * 2;
    const size_t tstep = 2 * hstep;
    const unsigned ldsw = (unsigned)wid * 1024u;
    const int aoff = lds_byte(wr * 64 + fr, fq * 8), boff = lds_byte(wc * 32 + fr, fq * 8);
#define PG8_SA(b, h) (((b) * 2 + (h)) * HTB)
#define PG8_SB(b, h) ((4 + (b) * 2 + (h)) * HTB)
#define PG8_STAGE(bufoff, gbase, voff) do { _Pragma("unroll") for (int _i = 0; _i < 2; ++_i) \
        __builtin_amdgcn_global_load_lds((const unsigned*)((const char*)(gbase) + (voff)[_i]), (PG8_LAS unsigned*)(lds + (bufoff) + ldsw + _i * 8192), 16, 0, 0); } while (0)
#define PG8_LDA(dst, b, h) do { _Pragma("unroll") for (int m = 0; m < 4; ++m) _Pragma("unroll") for (int k = 0; k < 2; ++k) dst[m][k] = *(const PG8_LAS bf16x8*)(lds + PG8_SA(b, h) + aoff + m * 2048 + k * 1024); } while (0)
#define PG8_LDB(dst, b, h) do { _Pragma("unroll") for (int n = 0; n < 2; ++n) _Pragma("unroll") for (int k = 0; k < 2; ++k) dst[n][k] = *(const PG8_LAS bf16x8*)(lds + PG8_SB(b, h) + boff + n * 2048 + k * 1024); } while (0)
#define PG8_MMA(ai, bj, At, Bt) do { __builtin_amdgcn_s_setprio(1); _Pragma("unroll") for (int m = 0; m < 4; ++m) _Pragma("unroll") for (int n = 0; n < 2; ++n) _Pragma("unroll") for (int k = 0; k < 2; ++k) \
        acc[ai][bj][m][n] = __builtin_amdgcn_mfma_f32_16x16x32_bf16(Bt[n][k], At[m][k], acc[ai][bj][m][n], 0, 0, 0); __builtin_amdgcn_s_setprio(0); } while (0)
#define PG8_WAIT_V(n) asm volatile("s_waitcnt vmcnt(" #n ")" ::: "memory")
#define PG8_WAIT_L(n) asm volatile("s_waitcnt lgkmcnt(" #n ")" ::: "memory")
#define PG8_BAR __builtin_amdgcn_s_barrier()
#define PG8_SCHED __builtin_amdgcn_sched_barrier(0)
    Unit cur, nxt; int ui = 0;
    if (!S.next(0, cur)) return;
    f32x4 acc[2][2][4][2];
#pragma unroll
    for (int a = 0; a < 2; ++a)
#pragma unroll
        for (int b = 0; b < 2; ++b)
#pragma unroll
            for (int m = 0; m < 4; ++m)
#pragma unroll
                for (int n = 0; n < 2; ++n) acc[a][b][m][n] = (f32x4){0.f, 0.f, 0.f, 0.f};
    bf16x8 At[4][2], B0[2][2], B1[2][2];
    const char* cA = (const char*)g.A + (size_t)cur.pm * tstep; const char* cB = (const char*)g.Bt + (size_t)cur.pn * tstep;
    S.a_ready(cur);
    if constexpr (SP2) {
        PG8_STAGE(PG8_SB(0, 0), cB, voffB); PG8_STAGE(PG8_SB(0, 1), cB + hstep, voffB); PG8_STAGE(PG8_SA(0, 0), cA, voffA); PG8_STAGE(PG8_SA(0, 1), cA + hstep, voffA);
        if (wr == 1) PG8_BAR;
        PG8_WAIT_V(2); PG8_BAR;
        PG8_STAGE(PG8_SB(1, 0), cB + kstep, voffB); PG8_STAGE(PG8_SA(1, 0), cA + kstep, voffA); PG8_STAGE(PG8_SB(1, 1), cB + hstep + kstep, voffB);
        PG8_WAIT_V(6); PG8_BAR;
    } else {
        PG8_STAGE(PG8_SB(0, 0), cB, voffB); PG8_STAGE(PG8_SA(0, 0), cA, voffA); PG8_STAGE(PG8_SB(0, 1), cB + hstep, voffB); PG8_STAGE(PG8_SA(0, 1), cA + hstep, voffA);
        if (wr == 1) PG8_BAR;
        PG8_WAIT_V(4); PG8_BAR;
        PG8_STAGE(PG8_SB(1, 0), cB + kstep, voffB); PG8_STAGE(PG8_SA(1, 0), cA + kstep, voffA); PG8_STAGE(PG8_SB(1, 1), cB + hstep + kstep, voffB);
        PG8_WAIT_V(6); PG8_BAR;
    }
    for (;;) {
        const bool has_next = S.next(ui + 1, nxt);
        const char* nA = has_next ? (const char*)g.A + (size_t)nxt.pm * tstep : cA; const char* nB = has_next ? (const char*)g.Bt + (size_t)nxt.pn * tstep : cB;
        for (int t = 0; t < nt; t += 2) {
            const bool last = (t == nt - 2);
            const char* a1 = cA + (size_t)(t + 1) * kstep;
            const char* a2 = last ? nA : cA + (size_t)(t + 2) * kstep; const char* b2 = last ? nB : cB + (size_t)(t + 2) * kstep;
            const char* a3 = a2 + kstep; const char* b3 = b2 + kstep;
            if (last && has_next) S.a_ready(nxt);
            if constexpr (SP2) {
            PG8_LDB(B0, 0, 0); PG8_LDB(B1, 0, 1); PG8_SCHED; PG8_LDA(At, 0, 0); PG8_STAGE(PG8_SA(1, 1), a1 + hstep, voffA);
            PG8_WAIT_V(8); PG8_WAIT_L(0); PG8_BAR; PG8_MMA(0, 0, At, B0); PG8_MMA(0, 1, At, B1); PG8_BAR; PG8_SCHED;
            PG8_LDA(At, 0, 1); PG8_STAGE(PG8_SB(0, 0), b2, voffB); PG8_STAGE(PG8_SB(0, 1), b2 + hstep, voffB); PG8_STAGE(PG8_SA(0, 0), a2, voffA);
            PG8_WAIT_V(8); PG8_WAIT_L(0); PG8_BAR; PG8_MMA(1, 0, At, B0); PG8_MMA(1, 1, At, B1); PG8_BAR; PG8_SCHED;
            PG8_LDB(B0, 1, 0); PG8_LDB(B1, 1, 1); PG8_SCHED; PG8_LDA(At, 1, 0); PG8_STAGE(PG8_SA(0, 1), a2 + hstep, voffA);
            PG8_WAIT_V(8); PG8_WAIT_L(0); PG8_BAR; PG8_MMA(0, 0, At, B0); PG8_MMA(0, 1, At, B1); PG8_BAR; PG8_SCHED;
            PG8_LDA(At, 1, 1); PG8_STAGE(PG8_SB(1, 0), b3, voffB); PG8_STAGE(PG8_SB(1, 1), b3 + hstep, voffB); PG8_STAGE(PG8_SA(1, 0), a3, voffA);
            PG8_WAIT_V(8); PG8_WAIT_L(0); PG8_BAR; PG8_MMA(1, 0, At, B0); PG8_MMA(1, 1, At, B1); PG8_BAR; PG8_SCHED;
            } else {
            PG8_LDB(B0, 0, 0); PG8_SCHED; PG8_LDA(At, 0, 0); PG8_STAGE(PG8_SA(1, 1), a1 + hstep, voffA);
            PG8_WAIT_L(8); PG8_BAR; PG8_WAIT_L(0); PG8_MMA(0, 0, At, B0); PG8_BAR; PG8_SCHED;
            PG8_LDB(B1, 0, 1); PG8_STAGE(PG8_SB(0, 0), b2, voffB);
            PG8_BAR; PG8_WAIT_L(0); PG8_MMA(0, 1, At, B1); PG8_BAR;
            PG8_LDA(At, 0, 1); PG8_STAGE(PG8_SA(0, 0), a2, voffA);
            PG8_BAR; PG8_WAIT_L(0); PG8_MMA(1, 0, At, B0); PG8_BAR; PG8_SCHED;
            PG8_STAGE(PG8_SB(0, 1), b2 + hstep, voffB);
            PG8_WAIT_V(6); PG8_BAR; PG8_MMA(1, 1, At, B1); PG8_BAR;
            PG8_LDB(B0, 1, 0); PG8_SCHED; PG8_LDA(At, 1, 0); PG8_STAGE(PG8_SA(0, 1), a2 + hstep, voffA);
            PG8_WAIT_L(8); PG8_BAR; PG8_WAIT_L(0); PG8_MMA(0, 0, At, B0); PG8_BAR; PG8_SCHED;
            PG8_LDB(B1, 1, 1); PG8_STAGE(PG8_SB(1, 0), b3, voffB);
            PG8_BAR; PG8_WAIT_L(0); PG8_MMA(0, 1, At, B1); PG8_BAR;
            PG8_LDA(At, 1, 1); PG8_STAGE(PG8_SA(1, 0), a3, voffA);
            PG8_BAR; PG8_WAIT_L(0); PG8_MMA(1, 0, At, B0); PG8_BAR; PG8_SCHED;
            PG8_STAGE(PG8_SB(1, 1), b3 + hstep, voffB);
            PG8_WAIT_V(6); PG8_BAR; PG8_MMA(1, 1, At, B1); PG8_BAR;
            }
        }
        if constexpr (ALIGN_EPI) { if (wr == 0) PG8_BAR; }
        if constexpr (!Epi::AFTER_DRAIN) { E(acc, cur, wr, wc, fr, fq); S.done(cur); }
        if (!has_next) break;
#pragma unroll
        for (int a = 0; a < 2; ++a)
#pragma unroll
            for (int b = 0; b < 2; ++b)
#pragma unroll
                for (int m = 0; m < 4; ++m)
#pragma unroll
                    for (int n = 0; n < 2; ++n) acc[a][b][m][n] = (f32x4){0.f, 0.f, 0.f, 0.f};
        cur = nxt; cA = nA; cB = nB; ++ui;
        if constexpr (ALIGN_EPI) { if (wr == 1) PG8_BAR; }
    }
    PG8_WAIT_V(0);
    if constexpr (!ALIGN_EPI) { if (wr == 0) PG8_BAR; }
    PG8_BAR;
    if constexpr (Epi::AFTER_DRAIN) { E.fused(acc, cur, wr, wc, fr, fq, lds, wid, lane); S.done(cur); }
#undef PG8_SA
#undef PG8_SB
#undef PG8_STAGE
#undef PG8_LDA
#undef PG8_LDB
#undef PG8_MMA
#undef PG8_WAIT_V
#undef PG8_WAIT_L
#undef PG8_BAR
#undef PG8_SCHED
}
}
#ifndef PG8_SP2
#define PG8_SP2 true
#endif
#ifndef PG8_ALIGN
#define PG8_ALIGN true
#endif

constexpr int NWAVES = 8, NTHR = NWAVES * 64;
constexpr int D = 1024, BATCH = 32, SEQ = 2048, T = BATCH * SEQ, TP = T + 256, NZ = 4352, FF = 4096, W_IN_LD = 4112;
constexpr int NCHUNK = SEQ / 64;
constexpr int META_PAD = 48;
constexpr float EPS = 1e-6f;
constexpr size_t MiB = 1u << 20;
constexpr size_t WS_WIN = 0, WS_WA = 9 * MiB, WS_WB = 10 * MiB, WS_WO = 11 * MiB, WS_W1 = 13 * MiB, WS_W2 = 21 * MiB;
constexpr size_t WS_CTL = 29 * MiB, CTL_BYTES = 16384;
constexpr size_t WS_SSQ = 30 * MiB;
constexpr size_t WS_U = 34 * MiB;
constexpr size_t WS_Z = 163 * MiB;
constexpr size_t ZROW = (size_t)TP;
constexpr size_t WS_A = WS_Z, WS_Q = WS_A + ZROW * 512 * 2, WS_K = WS_Q + ZROW * 256 * 2, WS_V = WS_K + ZROW * 256 * 2, WS_R = WS_V + ZROW * 512 * 2,
                 WS_LA = WS_R + ZROW * 512 * 2, WS_GA = WS_LA + ZROW * 256 * 4, WS_GB = WS_GA + ZROW * 1024 * 2, WS_ZEND = WS_GB + ZROW * 1024 * 2;
constexpr size_t WS_PA = 742 * MiB, WS_ON = 806 * MiB, WS_U2 = 870 * MiB, WS_END = 998 * MiB;
constexpr size_t WS_HD = WS_Z;
static_assert(WS_ZEND <= WS_PA && WS_HD + (size_t)T * FF * 2 <= WS_PA && WS_U + ZROW * 2048 <= WS_Z, "ws map");
constexpr int LDS_BYTES = 132096;

#define GAS __attribute__((address_space(1)))
#define LAS __attribute__((address_space(3)))
typedef unsigned short bf16;
typedef unsigned v4u __attribute__((ext_vector_type(4)));
typedef unsigned v2u __attribute__((ext_vector_type(2)));
typedef float f32x4 __attribute__((ext_vector_type(4)));
typedef short bf16x8 __attribute__((ext_vector_type(8)));
using pg8::cvt_pk_bf16; using pg8::bf_lo; using pg8::bf_hi;
#define LDS_WAIT() asm volatile("s_waitcnt lgkmcnt(0)" ::: "memory")

__device__ __forceinline__ float wave_sum(float v) {
#pragma unroll
    for (int o = 1; o < 64; o <<= 1) v += __shfl_xor(v, o);
    return v;
}
__device__ __forceinline__ void tr_item(const float* W, int ldw, int src_col0, int K, int ncols, bf16* WT, int dst_row0, LAS float* scr, int item, int lane) {
    const int nblk = ncols / 32, kb = item / nblk, nb = item % nblk, k0 = 64 * kb, n0 = 32 * nb;
#pragma unroll 8
    for (int i = 0; i < 32; ++i) { const int kk = 2 * i + (lane >> 5); scr[kk * 33 + (lane & 31)] = W[(size_t)(k0 + kk) * ldw + src_col0 + n0 + (lane & 31)]; }
    LDS_WAIT(); asm volatile("" ::: "memory");
    const int c = lane & 7;
#pragma unroll
    for (int j = 0; j < 4; ++j) { const int n = (lane >> 3) + 8 * j; const LAS float* s = scr + (8 * c) * 33 + n;
        v4u o; o.x = cvt_pk_bf16(s[0 * 33], s[1 * 33]); o.y = cvt_pk_bf16(s[2 * 33], s[3 * 33]); o.z = cvt_pk_bf16(s[4 * 33], s[5 * 33]); o.w = cvt_pk_bf16(s[6 * 33], s[7 * 33]);
        *(v4u*)(WT + (size_t)(dst_row0 + n0 + n) * K + k0 + 8 * c) = o; }
    LDS_WAIT(); asm volatile("" ::: "memory");
}
__device__ __forceinline__ void rms_row_to_bf16(const float* xrow, const f32x4 (&g)[4], bf16* orow, int lane) {
    const f32x4* xr = (const f32x4*)xrow + lane;
    f32x4 v[4]; float s = 0.f;
#pragma unroll
    for (int j = 0; j < 4; ++j) { v[j] = xr[64 * j]; s += (v[j].x * v[j].x + v[j].y * v[j].y) + (v[j].z * v[j].z + v[j].w * v[j].w); }
    const float rstd = __builtin_amdgcn_rsqf(wave_sum(s) * (1.f / D) + EPS);
    v2u* o8 = (v2u*)orow + lane;
#pragma unroll
    for (int j = 0; j < 4; ++j) { const f32x4 y = v[j] * rstd * g[j]; v2u w; w.x = cvt_pk_bf16(y.x, y.y); w.y = cvt_pk_bf16(y.z, y.w); o8[64 * j] = w; }
}

struct Ptrs {
    const float *x, *meta, *norm_mix, *w_in, *w_pool_mix, *pool_scale, *w_pool_out, *w_gate_up, *b_gate, *gla_norm, *w_gla_out, *w_out, *norm_ffn, *w_ff1, *w_ff2, *norm_final;
    float* out; unsigned char* ws;
};

__device__ __forceinline__ void p0_prologue(const Ptrs& P, LAS unsigned char* lds, int tid, int G) {
    const int lane = tid & 63, wave = tid >> 6;
    LAS float* scr = (LAS float*)(lds + wave * 16384);
    const int gw = blockIdx.x * NWAVES + wave, NGW = G * NWAVES;
    bf16* WIN = (bf16*)(P.ws + WS_WIN); bf16* WA = (bf16*)(P.ws + WS_WA); bf16* WB = (bf16*)(P.ws + WS_WB); bf16* WO = (bf16*)(P.ws + WS_WO);
    bf16* W1 = (bf16*)(P.ws + WS_W1); bf16* W2 = (bf16*)(P.ws + WS_W2); bf16* U = (bf16*)(P.ws + WS_U);
    constexpr int I_IN0 = 16 * 64, I_GA = 16 * 32, I_GB = 16 * 32, I_B = 8 * 32, I_O = 16 * 32, I_1 = 16 * 128, I_2 = 64 * 32;
    constexpr int NITEMS = I_IN0 + I_GA + I_GB + I_B + I_O + I_1 + I_2;
    for (int it = gw; it < NITEMS; it += NGW) {
        int r = it;
        if (r < I_IN0) { tr_item(P.w_in, W_IN_LD, 0, D, 2048, WIN, 0, scr, r, lane); continue; } r -= I_IN0;
        if (r < I_GA) { tr_item(P.w_in, W_IN_LD, 2064, D, 1024, WIN, 2304, scr, r, lane); continue; } r -= I_GA;
        if (r < I_GB) { tr_item(P.w_in, W_IN_LD, 3088, D, 1024, WIN, 3328, scr, r, lane); continue; } r -= I_GB;
        if (r < I_B) { tr_item(P.w_gla_out, D, 0, 512, 1024, WB, 0, scr, r, lane); continue; } r -= I_B;
        if (r < I_O) { tr_item(P.w_out, D, 0, D, 1024, WO, 0, scr, r, lane); continue; } r -= I_O;
        if (r < I_1) { tr_item(P.w_ff1, FF, 0, D, FF, W1, 0, scr, r, lane); continue; } r -= I_1;
        tr_item(P.w_ff2, D, 0, FF, 1024, W2, 0, scr, r, lane);
    }
    const int gt = blockIdx.x * NTHR + tid, NGT = G * NTHR;
    for (int task = gt; task < 256 * 128; task += NGT) {
        const int j = task & 255, k0 = (task >> 8) * 8; float wg[16];
#pragma unroll
        for (int r = 0; r < 16; ++r) wg[r] = P.w_gate_up[r * 256 + j];
        float o[8];
#pragma unroll
        for (int i = 0; i < 8; ++i) { const f32x4* wr = (const f32x4*)(P.w_in + (size_t)(k0 + i) * W_IN_LD + 2048); float s = 0.f;
#pragma unroll
            for (int q = 0; q < 4; ++q) { const f32x4 w4 = wr[q]; s += w4.x * wg[4 * q] + w4.y * wg[4 * q + 1] + w4.z * wg[4 * q + 2] + w4.w * wg[4 * q + 3]; }
            o[i] = s; }
        v4u w; w.x = cvt_pk_bf16(o[0], o[1]); w.y = cvt_pk_bf16(o[2], o[3]); w.z = cvt_pk_bf16(o[4], o[5]); w.w = cvt_pk_bf16(o[6], o[7]);
        *(v4u*)(WIN + (size_t)(2048 + j) * D + k0) = w;
    }
    for (int task = gt; task < 1024 * 128; task += NGT) {
        const int n = task & 1023, c0 = (task >> 10) * 4, g = c0 >> 7, cl0 = c0 & 127; float o[4] = {0.f, 0.f, 0.f, 0.f};
        const float* wm = P.w_pool_mix + ((size_t)g * 128 + cl0) * 128; const float* wpo = P.w_pool_out + (size_t)(g * 128) * D + n; const float* sc = P.pool_scale + g * 128;
#pragma unroll 4
        for (int e = 0; e < 128; e += 4) {
            const f32x4 s4 = *(const f32x4*)(sc + e); f32x4 m4[4]; float wp[4];
#pragma unroll
            for (int q = 0; q < 4; ++q) wp[q] = wpo[(size_t)(e + q) * D];
#pragma unroll
            for (int i = 0; i < 4; ++i) m4[i] = *(const f32x4*)(wm + i * 128 + e);
#pragma unroll
            for (int q = 0; q < 4; ++q) { const float w = wp[q] * s4[q];
#pragma unroll
                for (int i = 0; i < 4; ++i) o[i] += m4[i][q] * w; }
        }
        v2u w; w.x = cvt_pk_bf16(o[0], o[1]); w.y = cvt_pk_bf16(o[2], o[3]);
        *(v2u*)(WA + (size_t)n * 512 + c0) = w;
    }
    f32x4 g[4];
#pragma unroll
    for (int j = 0; j < 4; ++j) g[j] = ((const f32x4*)P.norm_mix)[lane + 64 * j];
    for (int m0 = gw; m0 < T; m0 += 4 * NGW) {
        f32x4 v[4][4];
#pragma unroll
        for (int i = 0; i < 4; ++i) { const int m = m0 + i * NGW; const f32x4* xr = (const f32x4*)(P.x + (size_t)(m < T ? m : m0) * D) + lane;
#pragma unroll
            for (int j = 0; j < 4; ++j) v[i][j] = xr[64 * j]; }
#pragma unroll
        for (int i = 0; i < 4; ++i) { const int m = m0 + i * NGW; float s = 0.f;
#pragma unroll
            for (int j = 0; j < 4; ++j) s += (v[i][j].x * v[i][j].x + v[i][j].y * v[i][j].y) + (v[i][j].z * v[i][j].z + v[i][j].w * v[i][j].w);
            const float rstd = __builtin_amdgcn_rsqf(wave_sum(s) * (1.f / D) + EPS);
            if (m < T) { v2u* o8 = (v2u*)(U + (size_t)m * D) + lane;
#pragma unroll
                for (int j = 0; j < 4; ++j) { const f32x4 y = v[i][j] * rstd * g[j]; v2u w; w.x = cvt_pk_bf16(y.x, y.y); w.y = cvt_pk_bf16(y.z, y.w); o8[64 * j] = w; } } }
    }
    for (int m = gw; m < 256; m += NGW) {
        bf16* orow = U + (size_t)(T + m) * D;
        if (m >= META_PAD && m < META_PAD + 16) rms_row_to_bf16(P.meta + (size_t)(m - META_PAD) * D, g, orow, lane);
        else { v4u z = {0u, 0u, 0u, 0u}; ((v4u*)orow)[lane] = z; ((v4u*)orow)[lane + 64] = z; }
    }
}

constexpr int RS = 72;
__device__ __forceinline__ bf16x8 ldsv(const LAS bf16* p) { return *(const LAS bf16x8*)p; }
__device__ __forceinline__ void gla_item(LAS unsigned char* lds, int item, const bf16* Qg, const bf16* Kg, const bf16* Vg, const bf16* Rg, const float* LAg, const float* gn, bf16* ON, int tid) {
    const int b = item >> 2, h = item & 3;
    const int w = __builtin_amdgcn_readfirstlane(tid >> 6), lane = tid & 63, fr = lane & 15, fq = lane >> 4;
    LAS bf16* sQp = (LAS bf16*)lds; LAS bf16* sQm = sQp + 64 * RS; LAS bf16* sKm = sQm + 64 * RS; LAS bf16* sKp = sKm + 64 * RS; LAS bf16* sKeT = sKp + 64 * RS;
    LAS bf16* sVT = sKeT + 64 * RS; LAS bf16* sP = sVT + 128 * RS; LAS bf16* sST = sP + 64 * RS; LAS float* sD = (LAS float*)(sST + 128 * RS); LAS float* sSsq = sD + 64;
    const int tt = w & 3, vh = w >> 2;
    f32x4 Sacc[4], gnr[4];
#pragma unroll
    for (int j = 0; j < 4; ++j) { Sacc[j] = (f32x4){0.f, 0.f, 0.f, 0.f}; gnr[j] = *(const f32x4*)(gn + h * 128 + 64 * vh + 16 * j + 4 * fq); }
    v4u q8, k8, v16a, v16b; f32x4 la0, la1;
#ifdef EXP_NO_META
    for (int i = tid; i < 128 * RS / 2; i += NTHR) ((LAS unsigned*)sST)[i] = 0u;
    __syncthreads();
#endif
#define GLA_LOAD(c) do { const size_t row = ((c) == 0 ? (size_t)T : (size_t)b * SEQ + (size_t)((c) - 1) * 64) + lane; \
        q8 = *(const v4u*)(Qg + row * 256 + h * 64 + 8 * w); k8 = *(const v4u*)(Kg + row * 256 + h * 64 + 8 * w); \
        la0 = *(const f32x4*)(LAg + row * 256 + h * 64 + 8 * w); la1 = *(const f32x4*)(LAg + row * 256 + h * 64 + 8 * w + 4); \
        v16a = *(const v4u*)(Vg + row * 512 + h * 128 + 16 * w); v16b = *(const v4u*)(Vg + row * 512 + h * 128 + 16 * w + 8); } while (0)
#ifdef EXP_NO_META
    GLA_LOAD(1);
    for (int c = 1; c <= NCHUNK; ++c) {
#else
    GLA_LOAD(0);
    v2u ysave[4]; size_t orow_prev = 0;
    for (int c = 0; c <= NCHUNK; ++c) {
#endif
        float bc[8] = {la0.x, la0.y, la0.z, la0.w, la1.x, la1.y, la1.z, la1.w};
        if (c == 0 && lane < META_PAD) {
#pragma unroll
            for (int i = 0; i < 8; ++i) bc[i] = 0.f; }
#pragma unroll
        for (int i = 0; i < 8; ++i) {
#pragma unroll
            for (int d = 1; d < 64; d <<= 1) { const float n = __shfl_up(bc[i], d); if (lane >= d) bc[i] += n; } }
        float qf[8] = {bf_lo(q8.x), bf_hi(q8.x), bf_lo(q8.y), bf_hi(q8.y), bf_lo(q8.z), bf_hi(q8.z), bf_lo(q8.w), bf_hi(q8.w)};
        float kf[8] = {bf_lo(k8.x), bf_hi(k8.x), bf_lo(k8.y), bf_hi(k8.y), bf_lo(k8.z), bf_hi(k8.z), bf_lo(k8.w), bf_hi(k8.w)};
        float qp[8], qm[8], km[8], kp[8], ke[8], dd[8];
#pragma unroll
        for (int i = 0; i < 8; ++i) { const float be = __shfl(bc[i], 63); const float eb = __expf(bc[i]), emb = __expf(-bc[i]), ek = __expf(be - bc[i]);
            qp[i] = qf[i] * eb; qm[i] = qf[i] * emb; km[i] = kf[i] * emb; kp[i] = kf[i] * eb; ke[i] = kf[i] * ek; dd[i] = __expf(be); }
        {
            v4u o;
            o.x = cvt_pk_bf16(qp[0], qp[1]); o.y = cvt_pk_bf16(qp[2], qp[3]); o.z = cvt_pk_bf16(qp[4], qp[5]); o.w = cvt_pk_bf16(qp[6], qp[7]); *(LAS v4u*)(sQp + lane * RS + 8 * w) = o;
            o.x = cvt_pk_bf16(qm[0], qm[1]); o.y = cvt_pk_bf16(qm[2], qm[3]); o.z = cvt_pk_bf16(qm[4], qm[5]); o.w = cvt_pk_bf16(qm[6], qm[7]); *(LAS v4u*)(sQm + lane * RS + 8 * w) = o;
            o.x = cvt_pk_bf16(km[0], km[1]); o.y = cvt_pk_bf16(km[2], km[3]); o.z = cvt_pk_bf16(km[4], km[5]); o.w = cvt_pk_bf16(km[6], km[7]); *(LAS v4u*)(sKm + lane * RS + 8 * w) = o;
            o.x = cvt_pk_bf16(kp[0], kp[1]); o.y = cvt_pk_bf16(kp[2], kp[3]); o.z = cvt_pk_bf16(kp[4], kp[5]); o.w = cvt_pk_bf16(kp[6], kp[7]); *(LAS v4u*)(sKp + lane * RS + 8 * w) = o;
        }
#pragma unroll
        for (int i = 0; i < 8; i += 2) { const unsigned pk = cvt_pk_bf16(ke[i], ke[i + 1]); sKeT[(8 * w + i) * RS + lane] = (bf16)(pk & 0xffffu); sKeT[(8 * w + i + 1) * RS + lane] = (bf16)(pk >> 16); }
        {
            const unsigned vv[8] = {v16a.x, v16a.y, v16a.z, v16a.w, v16b.x, v16b.y, v16b.z, v16b.w};
#pragma unroll
            for (int i = 0; i < 8; ++i) { sVT[(16 * w + 2 * i) * RS + lane] = (bf16)(vv[i] & 0xffffu); sVT[(16 * w + 2 * i + 1) * RS + lane] = (bf16)(vv[i] >> 16); }
        }
        if (lane == 0) {
#pragma unroll
            for (int i = 0; i < 8; ++i) sD[8 * w + i] = dd[i]; }
        if (c > 1) {
#pragma unroll
            for (int j = 0; j < 4; ++j) *(v2u*)(ON + orow_prev * 512 + h * 128 + 64 * vh + 16 * j + 4 * fq) = ysave[j]; }
        const int cn = (c < NCHUNK) ? c + 1 : c;
        GLA_LOAD(cn);
        v2u rr[4];
        const size_t orow = (size_t)b * SEQ + (size_t)(c > 0 ? c - 1 : 0) * 64 + 16 * tt + fr;
#pragma unroll
        for (int j = 0; j < 4; ++j) rr[j] = *(const v2u*)(Rg + orow * 512 + h * 128 + 64 * vh + 16 * j + 4 * fq);
        __syncthreads();
        f32x4 oacc[4];
#pragma unroll
        for (int j = 0; j < 4; ++j) oacc[j] = (f32x4){0.f, 0.f, 0.f, 0.f};
        if (c > 0) {
            const int st_t = w >> 1;
#pragma unroll
            for (int s2 = 0; s2 < 2; ++s2) { const int st = 2 * (w & 1) + s2; f32x4 a1 = {0.f, 0.f, 0.f, 0.f}, a2 = {0.f, 0.f, 0.f, 0.f};
                if (st <= st_t) {
#pragma unroll
                    for (int kk = 0; kk < 2; ++kk) a1 = __builtin_amdgcn_mfma_f32_16x16x32_bf16(ldsv(sKm + (16 * st + fr) * RS + 32 * kk + 8 * fq), ldsv(sQp + (16 * st_t + fr) * RS + 32 * kk + 8 * fq), a1, 0, 0, 0); }
                if (st >= st_t) {
#pragma unroll
                    for (int kk = 0; kk < 2; ++kk) a2 = __builtin_amdgcn_mfma_f32_16x16x32_bf16(ldsv(sKp + (16 * st + fr) * RS + 32 * kk + 8 * fq), ldsv(sQm + (16 * st_t + fr) * RS + 32 * kk + 8 * fq), a2, 0, 0, 0); }
                const int t = 16 * st_t + fr, s0 = 16 * st + 4 * fq; float p[4];
#pragma unroll
                for (int i = 0; i < 4; ++i) p[i] = (s0 + i <= t) ? a1[i] : a2[i];
                v2u o; o.x = cvt_pk_bf16(p[0], p[1]); o.y = cvt_pk_bf16(p[2], p[3]); *(LAS v2u*)(sP + t * RS + s0) = o; }
            {
                bf16x8 fs[4][2], fq2[2];
#pragma unroll
                for (int kk = 0; kk < 2; ++kk) fq2[kk] = ldsv(sQp + (16 * tt + fr) * RS + 32 * kk + 8 * fq);
#pragma unroll
                for (int j = 0; j < 4; ++j)
#pragma unroll
                    for (int kk = 0; kk < 2; ++kk) fs[j][kk] = ldsv(sST + (16 * (4 * vh + j) + fr) * RS + 32 * kk + 8 * fq);
#pragma unroll
                for (int j = 0; j < 4; ++j)
#pragma unroll
                    for (int kk = 0; kk < 2; ++kk) oacc[j] = __builtin_amdgcn_mfma_f32_16x16x32_bf16(fs[j][kk], fq2[kk], oacc[j], 0, 0, 0);
            }
        }
        __syncthreads();
        {
            bf16x8 fv[4][2], fp[2], fk[2];
#pragma unroll
            for (int j = 0; j < 4; ++j)
#pragma unroll
                for (int kk = 0; kk < 2; ++kk) fv[j][kk] = ldsv(sVT + (16 * (4 * vh + j) + fr) * RS + 32 * kk + 8 * fq);
#pragma unroll
            for (int kk = 0; kk < 2; ++kk) { fk[kk] = ldsv(sKeT + (16 * tt + fr) * RS + 32 * kk + 8 * fq); fp[kk] = ldsv(sP + (16 * tt + fr) * RS + 32 * kk + 8 * fq); }
            const f32x4 dv = *(const LAS f32x4*)(sD + 16 * tt + 4 * fq);
            if (c > 0) {
#pragma unroll
                for (int j = 0; j < 4; ++j)
#pragma unroll
                    for (int kk = 0; kk < 2; ++kk) oacc[j] = __builtin_amdgcn_mfma_f32_16x16x32_bf16(fv[j][kk], fp[kk], oacc[j], 0, 0, 0);
            }
#pragma unroll
            for (int j = 0; j < 4; ++j) { Sacc[j] = Sacc[j] * dv;
#pragma unroll
                for (int kk = 0; kk < 2; ++kk) Sacc[j] = __builtin_amdgcn_mfma_f32_16x16x32_bf16(fk[kk], fv[j][kk], Sacc[j], 0, 0, 0); }
#pragma unroll
            for (int j = 0; j < 4; ++j) { v2u o; o.x = cvt_pk_bf16(Sacc[j][0], Sacc[j][1]); o.y = cvt_pk_bf16(Sacc[j][2], Sacc[j][3]); *(LAS v2u*)(sST + (16 * (4 * vh + j) + fr) * RS + 16 * tt + 4 * fq) = o; }
        }
        float ss = 0.f;
#pragma unroll
        for (int j = 0; j < 4; ++j) ss += (oacc[j][0] * oacc[j][0] + oacc[j][1] * oacc[j][1]) + (oacc[j][2] * oacc[j][2] + oacc[j][3] * oacc[j][3]);
        ss += __shfl_xor(ss, 16); ss += __shfl_xor(ss, 32);
        if (fq == 0) sSsq[(16 * tt + fr) * 2 + vh] = ss;
        __syncthreads();
        if (c > 0) {
            const float tot = sSsq[(16 * tt + fr) * 2] + sSsq[(16 * tt + fr) * 2 + 1];
            const float rstd = __builtin_amdgcn_rsqf(tot * (1.0f / 128.0f) + EPS);
#pragma unroll
            for (int j = 0; j < 4; ++j) { const f32x4 rv = {bf_lo(rr[j].x), bf_hi(rr[j].x), bf_lo(rr[j].y), bf_hi(rr[j].y)}; const f32x4 y = oacc[j] * rstd * gnr[j] * rv;
                ysave[j].x = cvt_pk_bf16(y[0], y[1]); ysave[j].y = cvt_pk_bf16(y[2], y[3]); }
            orow_prev = orow;
        }
    }
#pragma unroll
    for (int j = 0; j < 4; ++j) *(v2u*)(ON + orow_prev * 512 + h * 128 + 64 * vh + 16 * j + 4 * fq) = ysave[j];
#undef GLA_LOAD
    __syncthreads();
}
__device__ __forceinline__ void pool_task(int task, const bf16* Ab, bf16* PA, int tid) {
    const int wave = tid >> 6, lane = tid & 63, b = task >> 3, i0 = (task & 7) * 256 + wave * 32;
    const int wd = 2 << (lane >> 4); const float inv = 1.0f / (float)wd;
    float sum[8];
#pragma unroll
    for (int e = 0; e < 8; ++e) sum[e] = 0.f;
#define AROW(i) ((i) >= 0 ? (size_t)b * SEQ + (size_t)(i) : (size_t)(T + 64 + (i)))
#define UNPK(w8, f) { f[0] = bf_lo(w8.x); f[1] = bf_hi(w8.x); f[2] = bf_lo(w8.y); f[3] = bf_hi(w8.y); f[4] = bf_lo(w8.z); f[5] = bf_hi(w8.z); f[6] = bf_lo(w8.w); f[7] = bf_hi(w8.w); }
    {
        v4u wv[15];
#pragma unroll
        for (int d = 1; d < 16; ++d) { const v4u z = {0u, 0u, 0u, 0u}; wv[d - 1] = (d < wd) ? *(const v4u*)(Ab + AROW(i0 - d) * 512 + 8 * lane) : z; }
#pragma unroll
        for (int d = 1; d < 16; ++d) { float f[8]; UNPK(wv[d - 1], f);
#pragma unroll
            for (int e = 0; e < 8; ++e) sum[e] += f[e]; }
    }
    for (int i4 = i0; i4 < i0 + 32; i4 += 4) {
        v4u c8[4], o8[4];
#pragma unroll
        for (int q = 0; q < 4; ++q) { c8[q] = *(const v4u*)(Ab + AROW(i4 + q) * 512 + 8 * lane); o8[q] = *(const v4u*)(Ab + AROW(i4 + q - wd + 1) * 512 + 8 * lane); }
#pragma unroll
        for (int q = 0; q < 4; ++q) { float cf[8], of[8], y[8]; UNPK(c8[q], cf); UNPK(o8[q], of);
#pragma unroll
            for (int e = 0; e < 8; ++e) { sum[e] += cf[e]; y[e] = sum[e] * inv - cf[e]; sum[e] -= of[e]; }
            v4u o; o.x = cvt_pk_bf16(y[0], y[1]); o.y = cvt_pk_bf16(y[2], y[3]); o.z = cvt_pk_bf16(y[4], y[5]); o.w = cvt_pk_bf16(y[6], y[7]);
            *(v4u*)(PA + ((size_t)b * SEQ + i4 + q) * 512 + 8 * lane) = o; }
    }
#undef AROW
#undef UNPK
}

#define XB_TMO      128
#define XB_XCNT(j)  (256  + 64 * (j))
#define XB_XSUB(j)  (1280 + 64 * (j))
#define XB_XGEN(j)  (2304 + 64 * (j))
#define XB_TOP      3328
#define XB_TOPGEN   3392
#define XCD_BAR_WORDS 3456
#define XB_SPIN_CAP (1u << 18)

__device__ __forceinline__ unsigned xb_ld(unsigned* p)              { return __hip_atomic_load(p, __ATOMIC_RELAXED, __HIP_MEMORY_SCOPE_AGENT); }
__device__ __forceinline__ unsigned xb_add(unsigned* p, unsigned v) { return __hip_atomic_fetch_add(p, v, __ATOMIC_RELAXED, __HIP_MEMORY_SCOPE_AGENT); }
__device__ __forceinline__ unsigned xb_xcc_id() { return (unsigned)__builtin_amdgcn_s_getreg((3 << 11) | 20) & 0xFu; }
#define XB_SPIN(cond, bar) do { unsigned _sp = 0; while (cond) { __builtin_amdgcn_s_sleep(1); \
    if ((++_sp & 255u) == 0u) { if (xb_ld(&(bar)[XB_TMO])) break; if (_sp > XB_SPIN_CAP) { atomicAdd(&(bar)[XB_TMO], 1u); break; } } } } while (0)

struct XcdBarrier {
    unsigned* bar; unsigned x;
    volatile LAS unsigned* st;
};

__device__ __forceinline__ XcdBarrier xcd_barrier_post(unsigned* bar, volatile LAS unsigned* st) {
    XcdBarrier b; b.bar = bar; b.x = xb_xcc_id(); b.st = st;
    if (threadIdx.x == 0) (void)xb_add(&bar[XB_XCNT(b.x)], 1u);
    return b;
}
__device__ __forceinline__ void xcd_barrier_complete(unsigned* bar, unsigned x, unsigned& nloc, unsigned& nx) {
    const unsigned G = gridDim.x * gridDim.y * gridDim.z;
    unsigned sum, cnt, mine, sp = 0u;
    for (;;) {
        sum = 0u; cnt = 0u; mine = 0u;
#pragma unroll
        for (unsigned j = 0; j < 16; ++j) { const unsigned c = xb_ld(&bar[XB_XCNT(j)]); sum += c; cnt += (c > 0u) ? 1u : 0u; mine = (j == x) ? c : mine; }
        if (sum == G) break;
        __builtin_amdgcn_s_sleep(1);
        if ((++sp & 255u) == 0u) { if (xb_ld(&bar[XB_TMO])) break; if (sp > XB_SPIN_CAP) { atomicAdd(&bar[XB_TMO], 1u); break; } }
    }
    nloc = mine > 0u ? mine : 1u; nx = cnt > 0u ? cnt : 1u;
}

__device__ __forceinline__ void xcd_barrier(const XcdBarrier& b) {
    asm volatile("s_waitcnt vmcnt(0)" ::: "memory");
    __syncthreads();
    if (threadIdx.x == 0) {
        unsigned* bar = b.bar;
        __builtin_amdgcn_s_waitcnt(0);
        unsigned nloc = b.st[0], nx = b.st[1];
        if (nloc == 0u) { xcd_barrier_complete(bar, b.x, nloc, nx); b.st[0] = nloc; b.st[1] = nx; }
        const unsigned old = xb_add(&bar[XB_XSUB(b.x)], 1u);
        const unsigned gen = old / nloc;
        if (old + 1u == (gen + 1u) * nloc) {
            __builtin_amdgcn_fence(__ATOMIC_RELEASE, "agent");
            asm volatile("s_waitcnt vmcnt(0)" ::: "memory");
            const unsigned og = xb_add(&bar[XB_TOP], 1u);
            const unsigned tg = og / nx;
            if (og + 1u == (tg + 1u) * nx) xb_add(&bar[XB_TOPGEN], 1u);
            else XB_SPIN(xb_ld(&bar[XB_TOPGEN]) == tg, bar);
            __builtin_amdgcn_fence(__ATOMIC_ACQUIRE, "agent");
            xb_add(&bar[XB_XGEN(b.x)], 1u);
            asm volatile("s_waitcnt vmcnt(0)" ::: "memory");
        } else {
            XB_SPIN(xb_ld(&bar[XB_XGEN(b.x)]) == gen, bar);
            __builtin_amdgcn_fence(__ATOMIC_ACQUIRE, "agent");
            asm volatile("s_waitcnt vmcnt(0)" ::: "memory");
        }
    }
    __syncthreads();
}

#define WSP(T_, off) ((T_*)(P.ws + (off)))
#ifndef STAGGER_TICKS
#define STAGGER_TICKS 0
#endif
__device__ __forceinline__ void stagger(const pg8::StaticOrder& S) {
    if (STAGGER_TICKS <= 0) return;
    pg8::Unit u0; if (!S.next(0, u0)) return;
    const unsigned long long t0 = __builtin_amdgcn_s_memrealtime();
    const unsigned long long wait = (unsigned long long)(u0.pm & 7) * STAGGER_TICKS;
    while (__builtin_amdgcn_s_memrealtime() - t0 < wait) __builtin_amdgcn_s_sleep(4);
}
__device__ __forceinline__ void phase_1(const Ptrs& P, LAS unsigned char* lds, int tid, int G) {
    pg8::Gemm g{WSP(bf16, WS_U), WSP(bf16, WS_WIN), TP, NZ, D}; pg8::StaticOrder S; S.init(TP, NZ, G, (int)blockIdx.x); stagger(S);
    pg8::EpiZ E{WSP(bf16, WS_A), WSP(bf16, WS_Q), WSP(bf16, WS_K), WSP(bf16, WS_V), WSP(bf16, WS_R), WSP(float, WS_LA), WSP(bf16, WS_GA), WSP(bf16, WS_GB), P.b_gate};
    pg8::gemm_phase<pg8::EpiZ, pg8::StaticOrder, PG8_ALIGN, PG8_SP2>(lds, g, S, E);
}
__device__ __forceinline__ void phase_2(const Ptrs& P, LAS unsigned char* lds, int tid, int G) {
    for (int item = blockIdx.x; item < BATCH * 4; item += G) gla_item(lds, item, WSP(bf16, WS_Q), WSP(bf16, WS_K), WSP(bf16, WS_V), WSP(bf16, WS_R), WSP(float, WS_LA), P.gla_norm, WSP(bf16, WS_ON), tid);
    if (G > 128) { for (int task = (int)blockIdx.x - 128; task >= 0 && task < 256; task += G - 128) pool_task(task, WSP(bf16, WS_A), WSP(bf16, WS_PA), tid); }
    else { for (int task = blockIdx.x; task < 256; task += G) pool_task(task, WSP(bf16, WS_A), WSP(bf16, WS_PA), tid); }
}
__device__ __forceinline__ void phase_3(const Ptrs& P, LAS unsigned char* lds, int tid, int G) {
    pg8::Gemm g{WSP(bf16, WS_PA), WSP(bf16, WS_WA), T, D, 512}; pg8::StaticOrder S; S.init(T, D, G, (int)blockIdx.x); stagger(S);
    pg8::EpiGate<false> E{WSP(bf16, WS_GA), WSP(bf16, WS_U)};
    pg8::gemm_phase<pg8::EpiGate<false>, pg8::StaticOrder, PG8_ALIGN, PG8_SP2>(lds, g, S, E);
}
__device__ __forceinline__ void phase_4(const Ptrs& P, LAS unsigned char* lds, int tid, int G) {
    pg8::Gemm g{WSP(bf16, WS_ON), WSP(bf16, WS_WB), T, D, 512}; pg8::StaticOrder S; S.init(T, D, G, (int)blockIdx.x); stagger(S);
    pg8::EpiGate<true> E{WSP(bf16, WS_GB), WSP(bf16, WS_U)};
    pg8::gemm_phase<pg8::EpiGate<true>, pg8::StaticOrder, PG8_ALIGN, PG8_SP2>(lds, g, S, E);
}
__device__ __forceinline__ void phase_5(const Ptrs& P, LAS unsigned char* lds, int tid, int G) {
    pg8::Gemm g{WSP(bf16, WS_U), WSP(bf16, WS_WO), T, D, D}; pg8::StaticOrder S; S.init(T, D, G, (int)blockIdx.x); stagger(S);
    pg8::EpiOut E{P.x, P.out, WSP(bf16, WS_U2), P.norm_ffn, WSP(float, WS_SSQ)};
    pg8::gemm_phase<pg8::EpiOut, pg8::StaticOrder, PG8_ALIGN, PG8_SP2>(lds, g, S, E);
}
__device__ __forceinline__ void phase_6(const Ptrs& P, LAS unsigned char* lds, int tid, int G, int skip = 0) {
    pg8::Gemm g{WSP(bf16, WS_U2), WSP(bf16, WS_W1), T, FF, D}; pg8::StaticOrder S; S.init(T, FF, G, (int)blockIdx.x); stagger(S);
    pg8::EpiFF1 E{WSP(float, WS_SSQ), WSP(bf16, WS_HD), skip};
    pg8::gemm_phase<pg8::EpiFF1, pg8::StaticOrder, PG8_ALIGN, PG8_SP2>(lds, g, S, E);
}
__device__ __forceinline__ void phase_7(const Ptrs& P, LAS unsigned char* lds, int tid, int G) {
    pg8::Gemm g{WSP(bf16, WS_HD), WSP(bf16, WS_W2), T, D, FF}; pg8::StaticOrder S; S.init(T, D, G, (int)blockIdx.x); stagger(S);
    pg8::EpiFF2 E{P.out};
    pg8::gemm_phase<pg8::EpiFF2, pg8::StaticOrder, PG8_ALIGN, PG8_SP2>(lds, g, S, E);
}
__device__ __forceinline__ void phase_8(const Ptrs& P, LAS unsigned char* lds, int tid, int G) {
    const int lane = tid & 63, gw = blockIdx.x * NWAVES + (tid >> 6), NGW = G * NWAVES;
    f32x4 g[4];
#pragma unroll
    for (int j = 0; j < 4; ++j) g[j] = ((const f32x4*)P.norm_final)[lane + 64 * j];
    for (int m0 = gw; m0 < T; m0 += 4 * NGW) {
        f32x4 v[4][4];
#pragma unroll
        for (int i = 0; i < 4; ++i) { const int m = m0 + i * NGW; const f32x4* xr = (const f32x4*)(P.out + (size_t)(m < T ? m : m0) * D) + lane;
#pragma unroll
            for (int j = 0; j < 4; ++j) v[i][j] = xr[64 * j]; }
#pragma unroll
        for (int i = 0; i < 4; ++i) { const int m = m0 + i * NGW; float s = 0.f;
#pragma unroll
            for (int j = 0; j < 4; ++j) s += (v[i][j].x * v[i][j].x + v[i][j].y * v[i][j].y) + (v[i][j].z * v[i][j].z + v[i][j].w * v[i][j].w);
            const float rstd = __builtin_amdgcn_rsqf(wave_sum(s) * (1.f / D) + EPS);
            if (m < T) { f32x4* xo = (f32x4*)(P.out + (size_t)m * D) + lane;
#pragma unroll
                for (int j = 0; j < 4; ++j) xo[64 * j] = v[i][j] * rstd * g[j]; } }
    }
}
__device__ __forceinline__ void phase_0(const Ptrs& P, LAS unsigned char* lds, int tid, int G) { p0_prologue(P, lds, tid, G); __syncthreads(); }

struct Args { Ptrs p; int ph_lo, ph_hi, coop, pad; };
__global__ void __launch_bounds__(NTHR, 2) hybrid_fwd(Args args) {
    extern __shared__ __attribute__((aligned(16))) unsigned char lds_raw[];
    cg::grid_group grid = cg::this_grid();
    LAS unsigned char* lds = (LAS unsigned char*)lds_raw;
    const Ptrs& P = args.p;
    const int tid = threadIdx.x, G = gridDim.x, lo = args.ph_lo, hi = args.ph_hi;
    volatile LAS unsigned* bst = (volatile LAS unsigned*)(lds + 131072);
    if (tid < 2) bst[tid] = 0u;
    __syncthreads();
    XcdBarrier bar; bar.bar = (unsigned*)(P.ws + WS_CTL); bar.x = 0; bar.st = bst;
    if (args.coop == 1) bar = xcd_barrier_post((unsigned*)(P.ws + WS_CTL), bst);
#define GSYNC() do { if (args.coop == 1) xcd_barrier(bar); else grid.sync(); } while (0)
#define IN(k) (lo <= (k) && (k) < hi)
#define SEAM(k) do { if (IN(k) && IN((k) + 1)) GSYNC(); } while (0)
#define DUP(k, body) do { if ((PROBE_DUP >> (k)) & 1) { GSYNC(); body; } } while (0)
    if (IN(0)) phase_0(P, lds, tid, G);
    DUP(0, phase_0(P, lds, tid, G));
    SEAM(0);
    if (IN(1)) phase_1(P, lds, tid, G);
    DUP(1, phase_1(P, lds, tid, G));
    SEAM(1);
    if (IN(2)) phase_2(P, lds, tid, G);
    DUP(2, phase_2(P, lds, tid, G));
    SEAM(2);
    if (IN(3)) phase_3(P, lds, tid, G);
    DUP(3, phase_3(P, lds, tid, G));
    SEAM(3);
    if (IN(4)) phase_4(P, lds, tid, G);
    DUP(4, { phase_3(P, lds, tid, G); GSYNC(); phase_4(P, lds, tid, G); });
    SEAM(4);
    if (IN(5)) phase_5(P, lds, tid, G);
    DUP(5, phase_5(P, lds, tid, G));
    SEAM(5);
    if (IN(6)) phase_6(P, lds, tid, G);
    DUP(6, phase_6(P, lds, tid, G, 1));
    SEAM(6);
    if (IN(7)) phase_7(P, lds, tid, G);
    DUP(7, { phase_5(P, lds, tid, G); GSYNC(); phase_7(P, lds, tid, G); });
    SEAM(7);
    if (IN(8)) phase_8(P, lds, tid, G);
#undef IN
#undef SEAM
#undef DUP
}

constexpr int N_PHASES = 9;
extern "C" void kernel_launch(void* const* d_in, const int* in_sizes, int n_in, void* d_out, int out_size, void* d_ws, size_t ws_size, hipStream_t stream) {
    static int grid = 0;
    if (grid == 0) {
        if (n_in != 16 || in_sizes[0] != T * D || out_size != T * D || ws_size < WS_END) { fprintf(stderr, "kernel_launch: unexpected shapes (n_in %d in0 %d out %d ws %zu)\n", n_in, n_in > 0 ? in_sizes[0] : -1, out_size, ws_size); grid = -1; return; }
        int dev = 0, cus = 0, per_cu = 0;
        hipGetDevice(&dev); hipDeviceGetAttribute(&cus, hipDeviceAttributeMultiprocessorCount, dev);
        if (hipFuncSetAttribute((const void*)hybrid_fwd, hipFuncAttributeMaxDynamicSharedMemorySize, LDS_BYTES) != hipSuccess) { fprintf(stderr, "kernel_launch: hipFuncSetAttribute failed\n"); grid = -1; return; }
        if (hipOccupancyMaxActiveBlocksPerMultiprocessor(&per_cu, (const void*)hybrid_fwd, NTHR, LDS_BYTES) != hipSuccess || per_cu < 1) { fprintf(stderr, "kernel_launch: occupancy query says %d\n", per_cu); per_cu = 1; }
        (void)hipGetLastError();
        grid = cus * 1;
        if (grid <= 0) grid = 256;
    }
    if (grid < 0) return;
    Args a{};
    Ptrs& p = a.p;
    p.x = (const float*)d_in[0]; p.meta = (const float*)d_in[1]; p.norm_mix = (const float*)d_in[2]; p.w_in = (const float*)d_in[3]; p.w_pool_mix = (const float*)d_in[4];
    p.pool_scale = (const float*)d_in[5]; p.w_pool_out = (const float*)d_in[6]; p.w_gate_up = (const float*)d_in[7]; p.b_gate = (const float*)d_in[8]; p.gla_norm = (const float*)d_in[9];
    p.w_gla_out = (const float*)d_in[10]; p.w_out = (const float*)d_in[11]; p.norm_ffn = (const float*)d_in[12]; p.w_ff1 = (const float*)d_in[13]; p.w_ff2 = (const float*)d_in[14];
    p.norm_final = (const float*)d_in[15]; p.out = (float*)d_out; p.ws = (unsigned char*)d_ws;
#if MK_N_LAUNCHES == 1
    if (hipMemsetAsync((char*)d_ws + WS_CTL, 0, CTL_BYTES, stream) != hipSuccess) { fprintf(stderr, "kernel_launch: memset of the barrier words failed\n"); return; }
    a.ph_lo = 0; a.ph_hi = N_PHASES; a.coop = 1;
    void* kargs[] = {&a};
    hipError_t e = hipLaunchCooperativeKernel((const void*)hybrid_fwd, dim3(grid), dim3(NTHR), kargs, LDS_BYTES, stream);
    if (e != hipSuccess) fprintf(stderr, "kernel_launch: cooperative launch failed: %s (grid %d)\n", hipGetErrorString(e), grid);
#else
    for (int ph = 0; ph < N_PHASES; ++ph) { a.ph_lo = ph; a.ph_hi = ph + 1; a.coop = 0;
        hipLaunchKernelGGL(hybrid_fwd, dim3(grid), dim3(NTHR), LDS_BYTES, stream, a); }
#endif
}
```

```cpp
#include <hip/hip_runtime.h>
#include <hip/hip_cooperative_groups.h>
#include <cstdio>
#include <cstdint>
namespace cg = cooperative_groups;

#ifndef PROBE_DUP
#define PROBE_DUP 0
#endif
#ifndef MK_N_LAUNCHES
#define MK_N_LAUNCHES 1
#endif

namespace pg8 {
#define PG8_LAS __attribute__((address_space(3)))
typedef unsigned short bf16_t;
typedef short bf16x8 __attribute__((ext_vector_type(8)));
typedef float f32x4 __attribute__((ext_vector_type(4)));
typedef unsigned u32x4 __attribute__((ext_vector_type(4)));
constexpr int BM = 256, BK = 64, HALF = 128, HTB = HALF * BK * 2  , STAGE_BYTES = 8 * HTB, NXCD = 8, WGM = 8;

__host__ __device__ __forceinline__ int lds_byte(int r, int c) { const int st = (r >> 4) * 2 + (c >> 5), rr = r & 15, cc = c & 31, ob = rr * 64 + cc * 2; return st * 1024 + (ob ^ (((ob >> 9) & 1) << 5)); }
__host__ __device__ __forceinline__ void stage_rc(int b, int& R, int& C) { const int st = b / 1024, sb = b % 1024, swz = sb ^ (((sb >> 9) & 1) << 5); R = (st >> 1) * 16 + swz / 64; C = (st & 1) * 32 + (swz % 64) / 2; }
__host__ __device__ __forceinline__ int perm32(int rho) { const int n = rho >> 4, i = rho & 15; return 8 * (i >> 2) + 4 * n + (i & 3); }

struct Unit { int pm, pn; };
struct Gemm { const bf16_t* A; const bf16_t* Bt; int M, N, K; };

struct StaticOrder {
    int nM, nN, nwg, G, c;
    __host__ __device__ void init(int M, int N, int G_, int c_) { nM = M / BM; nN = N / BM; nwg = nM * nN; G = G_; c = c_; }
    __host__ __device__ bool next(int i, Unit& u) const {
        const long L = (long)i * G + c; if (L >= nwg) return false;
        int wgid = (int)L; { const int q = nwg / NXCD, r = nwg % NXCD, xcd = wgid % NXCD, off = wgid / NXCD; wgid = (xcd < r ? xcd * (q + 1) : r * (q + 1) + (xcd - r) * q) + off; }
        const int nig = WGM * nN, gid = wgid / nig, fm = gid * WGM, gsz = (nM - fm) < WGM ? (nM - fm) : WGM;
        u.pm = fm + ((wgid % nig) % gsz); u.pn = (wgid % nig) / gsz; return true;
    }
    __device__ __forceinline__ void a_ready(const Unit&) const {}
    __device__ __forceinline__ void done(const Unit&) const {}
};

typedef float f32x2_t __attribute__((ext_vector_type(2))); typedef __bf16 bf16x2_t __attribute__((ext_vector_type(2)));
__device__ __forceinline__ unsigned cvt_pk_bf16(float lo, float hi) { f32x2_t v = {lo, hi}; bf16x2_t b = __builtin_convertvector(v, bf16x2_t); return __builtin_bit_cast(unsigned, b); }
typedef unsigned u32x2 __attribute__((ext_vector_type(2)));
__device__ __forceinline__ float bf_lo(unsigned w) { return __uint_as_float(w << 16); }
__device__ __forceinline__ float bf_hi(unsigned w) { return __uint_as_float(w & 0xffff0000u); }
__device__ __forceinline__ float sigm(float v) { return __builtin_amdgcn_rcpf(1.0f + __expf(-v)); }
__device__ __forceinline__ float logsig(float v) { return fminf(v, 0.f) - __logf(1.0f + __expf(-fabsf(v))); }
__device__ __forceinline__ u32x4 pack8(f32x4 v0, f32x4 v1) { u32x4 w; w.x = cvt_pk_bf16(v0[0], v0[1]); w.y = cvt_pk_bf16(v0[2], v0[3]); w.z = cvt_pk_bf16(v1[0], v1[1]); w.w = cvt_pk_bf16(v1[2], v1[3]); return w; }

struct EpiZ {
    static constexpr bool PERM = true, AFTER_DRAIN = false;
    bf16_t* Ab; bf16_t* Qb; bf16_t* Kb; bf16_t* Vb; bf16_t* Rb; float* LAb; bf16_t* GAb; bf16_t* GBb; const float* bgate;
    template <int MODE> __device__ __forceinline__ void put(const f32x4 (&acc)[2][2][4][2], bf16_t* base, int ldc, int row0, int col0) const {
#pragma unroll
        for (int ai = 0; ai < 2; ++ai)
#pragma unroll
            for (int m = 0; m < 4; ++m) { bf16_t* rowp = base + (size_t)(row0 + ai * HALF + m * 16) * ldc + col0;
#pragma unroll
                for (int bj = 0; bj < 2; ++bj) { f32x4 v0 = acc[ai][bj][m][0], v1 = acc[ai][bj][m][1];
                    if (MODE == 1) { v0 = v0 * 0.125f; v1 = v1 * 0.125f; }
                    if (MODE == 2) {
#pragma unroll
                        for (int e = 0; e < 4; ++e) { v0[e] = v0[e] * sigm(v0[e]); v1[e] = v1[e] * sigm(v1[e]); } }
                    if (MODE == 3) {
#pragma unroll
                        for (int e = 0; e < 4; ++e) { v0[e] = sigm(v0[e]); v1[e] = sigm(v1[e]); } }
                    *(u32x4*)(rowp + bj * HALF) = pack8(v0, v1); } }
    }
    __device__ __forceinline__ void operator()(const f32x4 (&acc)[2][2][4][2], const Unit& u, int wr, int wc, int fr, int fq) const {
        const int pn = u.pn, row0 = u.pm * BM + wr * 64 + fr, cl = wc * 32 + 8 * fq;
        if (pn < 2) put<0>(acc, Ab, 512, row0, pn * 256 + cl);
        else if (pn == 2) put<1>(acc, Qb, 256, row0, cl);
        else if (pn == 3) put<0>(acc, Kb, 256, row0, cl);
        else if (pn < 6) put<0>(acc, Vb, 512, row0, (pn - 4) * 256 + cl);
        else if (pn < 8) put<2>(acc, Rb, 512, row0, (pn - 6) * 256 + cl);
        else if (pn == 8) {
#pragma unroll
            for (int bj = 0; bj < 2; ++bj) { const f32x4 b0 = *(const f32x4*)(bgate + cl + bj * HALF), b1 = *(const f32x4*)(bgate + cl + bj * HALF + 4);
#pragma unroll
                for (int ai = 0; ai < 2; ++ai)
#pragma unroll
                    for (int m = 0; m < 4; ++m) { float* p = LAb + (size_t)(row0 + ai * HALF + m * 16) * 256 + cl + bj * HALF;
                        f32x4 v0 = acc[ai][bj][m][0] + b0, v1 = acc[ai][bj][m][1] + b1;
#pragma unroll
                        for (int e = 0; e < 4; ++e) { v0[e] = logsig(v0[e]) * 0.0625f; v1[e] = logsig(v1[e]) * 0.0625f; }
                        *(f32x4*)p = v0; *(f32x4*)(p + 4) = v1; } }
        }
        else if (pn < 13) put<3>(acc, GAb, 1024, row0, (pn - 9) * 256 + cl);
        else put<3>(acc, GBb, 1024, row0, (pn - 13) * 256 + cl);
    }
};
template <bool ADD> struct EpiGate {
    static constexpr bool PERM = true, AFTER_DRAIN = false;
    const bf16_t* G; bf16_t* O;
    __device__ __forceinline__ void operator()(const f32x4 (&acc)[2][2][4][2], const Unit& u, int wr, int wc, int fr, int fq) const {
        const int row0 = u.pm * BM + wr * 64 + fr, col0 = u.pn * BM + wc * 32 + 8 * fq;
        if (!ADD) {
            u32x4 g[2][4][2];
#pragma unroll
            for (int ai = 0; ai < 2; ++ai)
#pragma unroll
                for (int m = 0; m < 4; ++m)
#pragma unroll
                    for (int bj = 0; bj < 2; ++bj) g[ai][m][bj] = *(const u32x4*)(G + (size_t)(row0 + ai * HALF + m * 16) * 1024 + col0 + bj * HALF);
#pragma unroll
            for (int ai = 0; ai < 2; ++ai)
#pragma unroll
                for (int m = 0; m < 4; ++m)
#pragma unroll
                    for (int bj = 0; bj < 2; ++bj) { const u32x4 gg = g[ai][m][bj]; f32x4 v0 = acc[ai][bj][m][0], v1 = acc[ai][bj][m][1];
                        v0 = v0 * (f32x4){bf_lo(gg.x), bf_hi(gg.x), bf_lo(gg.y), bf_hi(gg.y)}; v1 = v1 * (f32x4){bf_lo(gg.z), bf_hi(gg.z), bf_lo(gg.w), bf_hi(gg.w)};
                        *(u32x4*)(O + (size_t)(row0 + ai * HALF + m * 16) * 1024 + col0 + bj * HALF) = pack8(v0, v1); }
        } else {
#pragma unroll
            for (int ai = 0; ai < 2; ++ai) {
                u32x4 g[4][2], t[4][2];
#pragma unroll
                for (int m = 0; m < 4; ++m)
#pragma unroll
                    for (int bj = 0; bj < 2; ++bj) { const size_t ro = (size_t)(row0 + ai * HALF + m * 16) * 1024 + col0 + bj * HALF; g[m][bj] = *(const u32x4*)(G + ro); t[m][bj] = *(const u32x4*)(O + ro); }
#pragma unroll
                for (int m = 0; m < 4; ++m)
#pragma unroll
                    for (int bj = 0; bj < 2; ++bj) { const u32x4 gg = g[m][bj], tt = t[m][bj]; f32x4 v0 = acc[ai][bj][m][0], v1 = acc[ai][bj][m][1];
                        v0 = v0 * (f32x4){bf_lo(gg.x), bf_hi(gg.x), bf_lo(gg.y), bf_hi(gg.y)} + (f32x4){bf_lo(tt.x), bf_hi(tt.x), bf_lo(tt.y), bf_hi(tt.y)};
                        v1 = v1 * (f32x4){bf_lo(gg.z), bf_hi(gg.z), bf_lo(gg.w), bf_hi(gg.w)} + (f32x4){bf_lo(tt.z), bf_hi(tt.z), bf_lo(tt.w), bf_hi(tt.w)};
                        *(u32x4*)(O + (size_t)(row0 + ai * HALF + m * 16) * 1024 + col0 + bj * HALF) = pack8(v0, v1); }
            }
        }
    }
};
struct EpiOut {
    static constexpr bool PERM = true, AFTER_DRAIN = false;
    const float* X; bf16_t* U2; float* ssq;
    __device__ __forceinline__ void operator()(const f32x4 (&acc)[2][2][4][2], const Unit& u, int wr, int wc, int fr, int fq) const {
        const int row0 = u.pm * BM + wr * 64 + fr, col0 = u.pn * BM + wc * 32 + 8 * fq;
#pragma unroll
        for (int ai = 0; ai < 2; ++ai) {
            f32x4 xv[4][2][2];
#pragma unroll
            for (int m = 0; m < 4; ++m)
#pragma unroll
                for (int bj = 0; bj < 2; ++bj) { const size_t ro = (size_t)(row0 + ai * HALF + m * 16) * 1024 + col0 + bj * HALF; xv[m][bj][0] = *(const f32x4*)(X + ro); xv[m][bj][1] = *(const f32x4*)(X + ro + 4); }
#pragma unroll
            for (int m = 0; m < 4; ++m) { const int row = row0 + ai * HALF + m * 16; const size_t ro = (size_t)row * 1024 + col0; float s = 0.f;
#pragma unroll
                for (int bj = 0; bj < 2; ++bj) { const f32x4 h0 = xv[m][bj][0] + acc[ai][bj][m][0], h1 = xv[m][bj][1] + acc[ai][bj][m][1];
                    s += (h0[0] * h0[0] + h0[1] * h0[1]) + (h0[2] * h0[2] + h0[3] * h0[3]) + (h1[0] * h1[0] + h1[1] * h1[1]) + (h1[2] * h1[2] + h1[3] * h1[3]);
                    *(u32x4*)(U2 + ro + bj * HALF) = pack8(h0, h1); }
                s += __shfl_xor(s, 16); s += __shfl_xor(s, 32);
                if (fq == 0) ssq[(size_t)row * 16 + u.pn * 4 + wc] = s; }
        }
    }
};
struct EpiFF1 {
    static constexpr bool PERM = true, AFTER_DRAIN = false;
    const float* ssq; bf16_t* Hd; int skip;
    __device__ __forceinline__ void operator()(const f32x4 (&acc)[2][2][4][2], const Unit& u, int wr, int wc, int fr, int fq) const {
        if (skip) { f32x4 t = {0.f, 0.f, 0.f, 0.f};
#pragma unroll
            for (int ai = 0; ai < 2; ++ai)
#pragma unroll
                for (int bj = 0; bj < 2; ++bj)
#pragma unroll
                    for (int m = 0; m < 4; ++m) t = t + acc[ai][bj][m][0] + acc[ai][bj][m][1];
            if (t[0] + t[1] + t[2] + t[3] == 123.456f) Hd[0] = 0; return; }
        const int row0 = u.pm * BM + wr * 64 + fr, col0 = u.pn * BM + wc * 32 + 8 * fq;
        f32x4 pv[2][4];
#pragma unroll
        for (int ai = 0; ai < 2; ++ai)
#pragma unroll
            for (int m = 0; m < 4; ++m) pv[ai][m] = *(const f32x4*)(ssq + (size_t)(row0 + ai * HALF + m * 16) * 16 + 4 * fq);
#pragma unroll
        for (int ai = 0; ai < 2; ++ai)
#pragma unroll
            for (int m = 0; m < 4; ++m) { const int row = row0 + ai * HALF + m * 16;
                const f32x4 p = pv[ai][m]; float s = (p[0] + p[1]) + (p[2] + p[3]);
                s += __shfl_xor(s, 16); s += __shfl_xor(s, 32);
                const float rstd = __builtin_amdgcn_rsqf(s * (1.0f / 1024.0f) + 1e-6f);
#pragma unroll
                for (int bj = 0; bj < 2; ++bj) { f32x4 v0 = acc[ai][bj][m][0] * rstd, v1 = acc[ai][bj][m][1] * rstd;
#pragma unroll
                    for (int e = 0; e < 4; ++e) { const float a = fmaxf(v0[e], 0.f), b = fmaxf(v1[e], 0.f); v0[e] = a * a; v1[e] = b * b; }
                    *(u32x4*)(Hd + (size_t)row * 4096 + col0 + bj * HALF) = pack8(v0, v1); } }
    }
};
struct EpiFF2 {
    static constexpr bool PERM = true, AFTER_DRAIN = false;
    const bf16_t* H1; bf16_t* H2;
    __device__ __forceinline__ void operator()(const f32x4 (&acc)[2][2][4][2], const Unit& u, int wr, int wc, int fr, int fq) const {
        const int row0 = u.pm * BM + wr * 64 + fr, col0 = u.pn * BM + wc * 32 + 8 * fq;
        u32x4 hv[2][4][2];
#pragma unroll
        for (int ai = 0; ai < 2; ++ai)
#pragma unroll
            for (int m = 0; m < 4; ++m)
#pragma unroll
                for (int bj = 0; bj < 2; ++bj) hv[ai][m][bj] = *(const u32x4*)(H1 + (size_t)(row0 + ai * HALF + m * 16) * 1024 + col0 + bj * HALF);
#pragma unroll
        for (int ai = 0; ai < 2; ++ai)
#pragma unroll
            for (int m = 0; m < 4; ++m)
#pragma unroll
                for (int bj = 0; bj < 2; ++bj) { const u32x4 t = hv[ai][m][bj];
                    const f32x4 v0 = acc[ai][bj][m][0] + (f32x4){bf_lo(t.x), bf_hi(t.x), bf_lo(t.y), bf_hi(t.y)}, v1 = acc[ai][bj][m][1] + (f32x4){bf_lo(t.z), bf_hi(t.z), bf_lo(t.w), bf_hi(t.w)};
                    *(u32x4*)(H2 + (size_t)(row0 + ai * HALF + m * 16) * 1024 + col0 + bj * HALF) = pack8(v0, v1); }
    }
};

template <class Epi, class Sched, bool ALIGN_EPI = false, bool SP2 = false>
__device__ __forceinline__ void gemm_phase(PG8_LAS unsigned char* lds, const Gemm g, const Sched& S, const Epi& E) {
    const int tid = threadIdx.x, wid = __builtin_amdgcn_readfirstlane(tid >> 6), lane = tid & 63, wr = wid >> 2, wc = wid & 3, fr = lane & 15, fq = lane >> 4;
    const int K = g.K, nt = K / BK;
    unsigned voffA[2], voffB[2];
#pragma unroll
    for (int i = 0; i < 2; ++i) { int R, C; stage_rc(tid * 16 + i * 8192, R, C); const int Rb = Epi::PERM ? ((R & ~31) + perm32(R & 31)) : R;
        voffA[i] = (unsigned)(R * K + C) * 2u; voffB[i] = (unsigned)(Rb * K + C) * 2u; }
    const size_t kstep = (size_t)(BK * 2);
    const size_t hstep = (size_t)HALF * K * 2;
    const size_t tstep = 2 * hstep;
    const unsigned ldsw = (unsigned)wid * 1024u;
    const int aoff = lds_byte(wr * 64 + fr, fq * 8), boff = lds_byte(wc * 32 + fr, fq * 8);
#define PG8_SA(b, h) (((b) * 2 + (h)) * HTB)
#define PG8_SB(b, h) ((4 + (b) * 2 + (h)) * HTB)
#define PG8_STAGE(bufoff, gbase, voff) do { _Pragma("unroll") for (int _i = 0; _i < 2; ++_i) \
        __builtin_amdgcn_global_load_lds((const unsigned*)((const char*)(gbase) + (voff)[_i]), (PG8_LAS unsigned*)(lds + (bufoff) + ldsw + _i * 8192), 16, 0, 0); } while (0)
#define PG8_LDA(dst, b, h) do { _Pragma("unroll") for (int m = 0; m < 4; ++m) _Pragma("unroll") for (int k = 0; k < 2; ++k) dst[m][k] = *(const PG8_LAS bf16x8*)(lds + PG8_SA(b, h) + aoff + m * 2048 + k * 1024); } while (0)
#define PG8_LDB(dst, b, h) do { _Pragma("unroll") for (int n = 0; n < 2; ++n) _Pragma("unroll") for (int k = 0; k < 2; ++k) dst[n][k] = *(const PG8_LAS bf16x8*)(lds + PG8_SB(b, h) + boff + n * 2048 + k * 1024); } while (0)
#define PG8_MMA(ai, bj, At, Bt) do { __builtin_amdgcn_s_setprio(1); _Pragma("unroll") for (int m = 0; m < 4; ++m) _Pragma("unroll") for (int n = 0; n < 2; ++n) _Pragma("unroll") for (int k = 0; k < 2; ++k) \
        acc[ai][bj][m][n] = __builtin_amdgcn_mfma_f32_16x16x32_bf16(Bt[n][k], At[m][k], acc[ai][bj][m][n], 0, 0, 0); __builtin_amdgcn_s_setprio(0); } while (0)
#define PG8_WAIT_V(n) asm volatile("s_waitcnt vmcnt(" #n ")" ::: "memory")
#define PG8_WAIT_L(n) asm volatile("s_waitcnt lgkmcnt(" #n ")" ::: "memory")
#define PG8_BAR __builtin_amdgcn_s_barrier()
#define PG8_SCHED __builtin_amdgcn_sched_barrier(0)
    Unit cur, nxt; int ui = 0;
    if (!S.next(0, cur)) return;
    f32x4 acc[2][2][4][2];
#pragma unroll
    for (int a = 0; a < 2; ++a)
#pragma unroll
        for (int b = 0; b < 2; ++b)
#pragma unroll
            for (int m = 0; m < 4; ++m)
#pragma unroll
                for (int n = 0; n < 2; ++n) acc[a][b][m][n] = (f32x4){0.f, 0.f, 0.f, 0.f};
    bf16x8 At[4][2], B0[2][2], B1[2][2];
    const char* cA = (const char*)g.A + (size_t)cur.pm * tstep; const char* cB = (const char*)g.Bt + (size_t)cur.pn * tstep;
    S.a_ready(cur);
    if constexpr (SP2) {
        PG8_STAGE(PG8_SB(0, 0), cB, voffB); PG8_STAGE(PG8_SB(0, 1), cB + hstep, voffB); PG8_STAGE(PG8_SA(0, 0), cA, voffA); PG8_STAGE(PG8_SA(0, 1), cA + hstep, voffA);
        if (wr == 1) PG8_BAR;
        PG8_WAIT_V(2); PG8_BAR;
        PG8_STAGE(PG8_SB(1, 0), cB + kstep, voffB); PG8_STAGE(PG8_SA(1, 0), cA + kstep, voffA); PG8_STAGE(PG8_SB(1, 1), cB + hstep + kstep, voffB);
        PG8_WAIT_V(6); PG8_BAR;
    } else {
        PG8_STAGE(PG8_SB(0, 0), cB, voffB); PG8_STAGE(PG8_SA(0, 0), cA, voffA); PG8_STAGE(PG8_SB(0, 1), cB + hstep, voffB); PG8_STAGE(PG8_SA(0, 1), cA + hstep, voffA);
        if (wr == 1) PG8_BAR;
        PG8_WAIT_V(4); PG8_BAR;
        PG8_STAGE(PG8_SB(1, 0), cB + kstep, voffB); PG8_STAGE(PG8_SA(1, 0), cA + kstep, voffA); PG8_STAGE(PG8_SB(1, 1), cB + hstep + kstep, voffB);
        PG8_WAIT_V(6); PG8_BAR;
    }
    for (;;) {
        const bool has_next = S.next(ui + 1, nxt);
        const char* nA = has_next ? (const char*)g.A + (size_t)nxt.pm * tstep : cA; const char* nB = has_next ? (const char*)g.Bt + (size_t)nxt.pn * tstep : cB;
        for (int t = 0; t < nt; t += 2) {
            const bool last = (t == nt - 2);
            const char* a1 = cA + (size_t)(t + 1) * kstep;
            const char* a2 = last ? nA : cA + (size_t)(t + 2) * kstep; const char* b2 = last ? nB : cB + (size_t)(t + 2) * kstep;
            const char* a3 = a2 + kstep; const char* b3 = b2 + kstep;
            if (last && has_next) S.a_ready(nxt);
            if constexpr (SP2) {
            PG8_LDB(B0, 0, 0); PG8_LDB(B1, 0, 1); PG8_SCHED; PG8_LDA(At, 0, 0); PG8_STAGE(PG8_SA(1, 1), a1 + hstep, voffA);
            PG8_WAIT_V(8); PG8_WAIT_L(0); PG8_BAR; PG8_MMA(0, 0, At, B0); PG8_MMA(0, 1, At, B1); PG8_BAR; PG8_SCHED;
            PG8_LDA(At, 0, 1); PG8_STAGE(PG8_SB(0, 0), b2, voffB); PG8_STAGE(PG8_SB(0, 1), b2 + hstep, voffB); PG8_STAGE(PG8_SA(0, 0), a2, voffA);
            PG8_WAIT_V(8); PG8_WAIT_L(0); PG8_BAR; PG8_MMA(1, 0, At, B0); PG8_MMA(1, 1, At, B1); PG8_BAR; PG8_SCHED;
            PG8_LDB(B0, 1, 0); PG8_LDB(B1, 1, 1); PG8_SCHED; PG8_LDA(At, 1, 0); PG8_STAGE(PG8_SA(0, 1), a2 + hstep, voffA);
            PG8_WAIT_V(8); PG8_WAIT_L(0); PG8_BAR; PG8_MMA(0, 0, At, B0); PG8_MMA(0, 1, At, B1); PG8_BAR; PG8_SCHED;
            PG8_LDA(At, 1, 1); PG8_STAGE(PG8_SB(1, 0), b3, voffB); PG8_STAGE(PG8_SB(1, 1), b3 + hstep, voffB); PG8_STAGE(PG8_SA(1, 0), a3, voffA);
            PG8_WAIT_V(8); PG8_WAIT_L(0); PG8_BAR; PG8_MMA(1, 0, At, B0); PG8_MMA(1, 1, At, B1); PG8_BAR; PG8_SCHED;
            } else {
            PG8_LDB(B0, 0, 0); PG8_SCHED; PG8_LDA(At, 0, 0); PG8_STAGE(PG8_SA(1, 1), a1 + hstep, voffA);
            PG8_WAIT_L(8); PG8_BAR; PG8_WAIT_L(0); PG8_MMA(0, 0, At, B0); PG8_BAR; PG8_SCHED;
            PG8_LDB(B1, 0, 1); PG8_STAGE(PG8_SB(0, 0), b2, voffB);
            PG8_BAR; PG8_WAIT_L(0); PG8_MMA(0, 1, At, B1); PG8_BAR;
            PG8_LDA(At, 0, 1); PG8_STAGE(PG8_SA(0, 0), a2, voffA);
            PG8_BAR; PG8_WAIT_L(0); PG8_MMA(1, 0, At, B0); PG8_BAR; PG8_SCHED;
            PG8_STAGE(PG8_SB(0, 1), b2 + hstep, voffB);
            PG8_WAIT_V(6); PG8_BAR; PG8_MMA(1, 1, At, B1); PG8_BAR;
            PG8_LDB(B0, 1, 0); PG8_SCHED; PG8_LDA(At, 1, 0); PG8_STAGE(PG8_SA(0, 1), a2 + hstep, voffA);
            PG8_WAIT_L(8); PG8_BAR; PG8_WAIT_L(0); PG8_MMA(0, 0, At, B0); PG8_BAR; PG8_SCHED;
            PG8_LDB(B1, 1, 1); PG8_STAGE(PG8_SB(1, 0), b3, voffB);
            PG8_BAR; PG8_WAIT_L(0); PG8_MMA(0, 1, At, B1); PG8_BAR;
            PG8_LDA(At, 1, 1); PG8_STAGE(PG8_SA(1, 0), a3, voffA);
            PG8_BAR; PG8_WAIT_L(0); PG8_MMA(1, 0, At, B0); PG8_BAR; PG8_SCHED;
            PG8_STAGE(PG8_SB(1, 1), b3 + hstep, voffB);
            PG8_WAIT_V(6); PG8_BAR; PG8_MMA(1, 1, At, B1); PG8_BAR;
            }
        }
        if constexpr (ALIGN_EPI) { if (wr == 0) PG8_BAR; }
        if constexpr (!Epi::AFTER_DRAIN) { E(acc, cur, wr, wc, fr, fq); S.done(cur); }
        if (!has_next) break;
#pragma unroll
        for (int a = 0; a < 2; ++a)
#pragma unroll
            for (int b = 0; b < 2; ++b)
#pragma unroll
                for (int m = 0; m < 4; ++m)
#pragma unroll
                    for (int n = 0; n < 2; ++n) acc[a][b][m][n] = (f32x4){0.f, 0.f, 0.f, 0.f};
        cur = nxt; cA = nA; cB = nB; ++ui;
        if constexpr (ALIGN_EPI) { if (wr == 1) PG8_BAR; }
    }
    PG8_WAIT_V(0);
    if constexpr (!ALIGN_EPI) { if (wr == 0) PG8_BAR; }
    PG8_BAR;
    if constexpr (Epi::AFTER_DRAIN) { E.fused(acc, cur, wr, wc, fr, fq, lds, wid, lane); S.done(cur); }
#undef PG8_SA
#undef PG8_SB
#undef PG8_STAGE
#undef PG8_LDA
#undef PG8_LDB
#undef PG8_MMA
#undef PG8_WAIT_V
#undef PG8_WAIT_L
#undef PG8_BAR
#undef PG8_SCHED
}
}
#ifndef PG8_SP2
#define PG8_SP2 true
#endif
#ifndef PG8_ALIGN
#define PG8_ALIGN true
#endif

constexpr int NWAVES = 8, NTHR = NWAVES * 64;
constexpr int D = 1024, BATCH = 32, SEQ = 2048, T = BATCH * SEQ, TP = T + 256, NZ = 4352, FF = 4096, W_IN_LD = 4112;
constexpr int NCHUNK = SEQ / 64;
constexpr int META_PAD = 48;
constexpr float EPS = 1e-6f;
constexpr size_t MiB = 1u << 20;
constexpr size_t WS_WIN = 0, WS_WA = 9 * MiB, WS_WB = 10 * MiB, WS_WO = 11 * MiB, WS_W1 = 13 * MiB, WS_W2 = 21 * MiB;
constexpr size_t WS_CTL = 29 * MiB, CTL_BYTES = 16384;
constexpr size_t WS_SSQ = 30 * MiB;
constexpr size_t WS_U = 34 * MiB;
constexpr size_t WS_Z = 163 * MiB;
constexpr size_t ZROW = (size_t)TP;
constexpr size_t WS_A = WS_Z, WS_Q = WS_A + ZROW * 512 * 2, WS_K = WS_Q + ZROW * 256 * 2, WS_V = WS_K + ZROW * 256 * 2, WS_R = WS_V + ZROW * 512 * 2,
                 WS_LA = WS_R + ZROW * 512 * 2, WS_GA = WS_LA + ZROW * 256 * 4, WS_GB = WS_GA + ZROW * 1024 * 2, WS_ZEND = WS_GB + ZROW * 1024 * 2;
constexpr size_t WS_PA = 742 * MiB, WS_ON = 806 * MiB, WS_U2 = 870 * MiB, WS_END = 998 * MiB;
constexpr size_t WS_HD = WS_Z;
static_assert(WS_ZEND <= WS_PA && WS_HD + (size_t)T * FF * 2 <= WS_PA && WS_U + ZROW * 2048 <= WS_Z, "ws map");
constexpr int LDS_BYTES = 132096;

#define GAS __attribute__((address_space(1)))
#define LAS __attribute__((address_space(3)))
typedef unsigned short bf16;
typedef unsigned v4u __attribute__((ext_vector_type(4)));
typedef unsigned v2u __attribute__((ext_vector_type(2)));
typedef float f32x4 __attribute__((ext_vector_type(4)));
typedef short bf16x8 __attribute__((ext_vector_type(8)));
using pg8::cvt_pk_bf16; using pg8::bf_lo; using pg8::bf_hi;
#define LDS_WAIT() asm volatile("s_waitcnt lgkmcnt(0)" ::: "memory")

__device__ __forceinline__ float wave_sum(float v) {
#pragma unroll
    for (int o = 1; o < 64; o <<= 1) v += __shfl_xor(v, o);
    return v;
}
__device__ __forceinline__ void tr_item(const float* W, int ldw, int src_col0, int K, int ncols, bf16* WT, int dst_row0, LAS float* scr, int item, int lane, const float* ks = nullptr) {
    const int nblk = ncols / 32, kb = item / nblk, nb = item % nblk, k0 = 64 * kb, n0 = 32 * nb;
#pragma unroll 8
    for (int i = 0; i < 32; ++i) { const int kk = 2 * i + (lane >> 5); scr[kk * 33 + (lane & 31)] = W[(size_t)(k0 + kk) * ldw + src_col0 + n0 + (lane & 31)] * (ks ? ks[k0 + kk] : 1.0f); }
    LDS_WAIT(); asm volatile("" ::: "memory");
    const int c = lane & 7;
#pragma unroll
    for (int j = 0; j < 4; ++j) { const int n = (lane >> 3) + 8 * j; const LAS float* s = scr + (8 * c) * 33 + n;
        v4u o; o.x = cvt_pk_bf16(s[0 * 33], s[1 * 33]); o.y = cvt_pk_bf16(s[2 * 33], s[3 * 33]); o.z = cvt_pk_bf16(s[4 * 33], s[5 * 33]); o.w = cvt_pk_bf16(s[6 * 33], s[7 * 33]);
        *(v4u*)(WT + (size_t)(dst_row0 + n0 + n) * K + k0 + 8 * c) = o; }
    LDS_WAIT(); asm volatile("" ::: "memory");
}
__device__ __forceinline__ void rms_row_to_bf16(const float* xrow, const f32x4 (&g)[4], bf16* orow, int lane) {
    const f32x4* xr = (const f32x4*)xrow + lane;
    f32x4 v[4]; float s = 0.f;
#pragma unroll
    for (int j = 0; j < 4; ++j) { v[j] = xr[64 * j]; s += (v[j].x * v[j].x + v[j].y * v[j].y) + (v[j].z * v[j].z + v[j].w * v[j].w); }
    const float rstd = __builtin_amdgcn_rsqf(wave_sum(s) * (1.f / D) + EPS);
    v2u* o8 = (v2u*)orow + lane;
#pragma unroll
    for (int j = 0; j < 4; ++j) { const f32x4 y = v[j] * rstd * g[j]; v2u w; w.x = cvt_pk_bf16(y.x, y.y); w.y = cvt_pk_bf16(y.z, y.w); o8[64 * j] = w; }
}

struct Ptrs {
    const float *x, *meta, *norm_mix, *w_in, *w_pool_mix, *pool_scale, *w_pool_out, *w_gate_up, *b_gate, *gla_norm, *w_gla_out, *w_out, *norm_ffn, *w_ff1, *w_ff2, *norm_final;
    float* out; unsigned char* ws;
};

__device__ __forceinline__ void p0_prologue(const Ptrs& P, LAS unsigned char* lds, int tid, int G) {
    const int lane = tid & 63, wave = tid >> 6;
    LAS float* scr = (LAS float*)(lds + wave * 16384);
    const int gw = blockIdx.x * NWAVES + wave, NGW = G * NWAVES;
    bf16* WIN = (bf16*)(P.ws + WS_WIN); bf16* WA = (bf16*)(P.ws + WS_WA); bf16* WB = (bf16*)(P.ws + WS_WB); bf16* WO = (bf16*)(P.ws + WS_WO);
    bf16* W1 = (bf16*)(P.ws + WS_W1); bf16* W2 = (bf16*)(P.ws + WS_W2); bf16* U = (bf16*)(P.ws + WS_U);
    constexpr int I_IN0 = 16 * 64, I_GA = 16 * 32, I_GB = 16 * 32, I_B = 8 * 32, I_O = 16 * 32, I_1 = 16 * 128, I_2 = 64 * 32;
    constexpr int NITEMS = I_IN0 + I_GA + I_GB + I_B + I_O + I_1 + I_2;
    for (int it = gw; it < NITEMS; it += NGW) {
        int r = it;
        if (r < I_IN0) { tr_item(P.w_in, W_IN_LD, 0, D, 2048, WIN, 0, scr, r, lane); continue; } r -= I_IN0;
        if (r < I_GA) { tr_item(P.w_in, W_IN_LD, 2064, D, 1024, WIN, 2304, scr, r, lane); continue; } r -= I_GA;
        if (r < I_GB) { tr_item(P.w_in, W_IN_LD, 3088, D, 1024, WIN, 3328, scr, r, lane); continue; } r -= I_GB;
        if (r < I_B) { tr_item(P.w_gla_out, D, 0, 512, 1024, WB, 0, scr, r, lane); continue; } r -= I_B;
        if (r < I_O) { tr_item(P.w_out, D, 0, D, 1024, WO, 0, scr, r, lane); continue; } r -= I_O;
        if (r < I_1) { tr_item(P.w_ff1, FF, 0, D, FF, W1, 0, scr, r, lane, P.norm_ffn); continue; } r -= I_1;
        tr_item(P.w_ff2, D, 0, FF, 1024, W2, 0, scr, r, lane);
    }
    const int gt = blockIdx.x * NTHR + tid, NGT = G * NTHR;
    for (int task = gt; task < 256 * 128; task += NGT) {
        const int j = task & 255, k0 = (task >> 8) * 8; float wg[16];
#pragma unroll
        for (int r = 0; r < 16; ++r) wg[r] = P.w_gate_up[r * 256 + j];
        float o[8];
#pragma unroll
        for (int i = 0; i < 8; ++i) { const f32x4* wr = (const f32x4*)(P.w_in + (size_t)(k0 + i) * W_IN_LD + 2048); float s = 0.f;
#pragma unroll
            for (int q = 0; q < 4; ++q) { const f32x4 w4 = wr[q]; s += w4.x * wg[4 * q] + w4.y * wg[4 * q + 1] + w4.z * wg[4 * q + 2] + w4.w * wg[4 * q + 3]; }
            o[i] = s; }
        v4u w; w.x = cvt_pk_bf16(o[0], o[1]); w.y = cvt_pk_bf16(o[2], o[3]); w.z = cvt_pk_bf16(o[4], o[5]); w.w = cvt_pk_bf16(o[6], o[7]);
        *(v4u*)(WIN + (size_t)(2048 + j) * D + k0) = w;
    }
    for (int task = gt; task < 1024 * 128; task += NGT) {
        const int n = task & 1023, c0 = (task >> 10) * 4, g = c0 >> 7, cl0 = c0 & 127; float o[4] = {0.f, 0.f, 0.f, 0.f};
        const float* wm = P.w_pool_mix + ((size_t)g * 128 + cl0) * 128; const float* wpo = P.w_pool_out + (size_t)(g * 128) * D + n; const float* sc = P.pool_scale + g * 128;
#pragma unroll 4
        for (int e = 0; e < 128; e += 4) {
            const f32x4 s4 = *(const f32x4*)(sc + e); f32x4 m4[4]; float wp[4];
#pragma unroll
            for (int q = 0; q < 4; ++q) wp[q] = wpo[(size_t)(e + q) * D];
#pragma unroll
            for (int i = 0; i < 4; ++i) m4[i] = *(const f32x4*)(wm + i * 128 + e);
#pragma unroll
            for (int q = 0; q < 4; ++q) { const float w = wp[q] * s4[q];
#pragma unroll
                for (int i = 0; i < 4; ++i) o[i] += m4[i][q] * w; }
        }
        v2u w; w.x = cvt_pk_bf16(o[0], o[1]); w.y = cvt_pk_bf16(o[2], o[3]);
        *(v2u*)(WA + (size_t)n * 512 + c0) = w;
    }
    f32x4 g[4];
#pragma unroll
    for (int j = 0; j < 4; ++j) g[j] = ((const f32x4*)P.norm_mix)[lane + 64 * j];
    for (int m0 = gw; m0 < T; m0 += 4 * NGW) {
        f32x4 v[4][4];
#pragma unroll
        for (int i = 0; i < 4; ++i) { const int m = m0 + i * NGW; const f32x4* xr = (const f32x4*)(P.x + (size_t)(m < T ? m : m0) * D) + lane;
#pragma unroll
            for (int j = 0; j < 4; ++j) v[i][j] = xr[64 * j]; }
#pragma unroll
        for (int i = 0; i < 4; ++i) { const int m = m0 + i * NGW; float s = 0.f;
#pragma unroll
            for (int j = 0; j < 4; ++j) s += (v[i][j].x * v[i][j].x + v[i][j].y * v[i][j].y) + (v[i][j].z * v[i][j].z + v[i][j].w * v[i][j].w);
            const float rstd = __builtin_amdgcn_rsqf(wave_sum(s) * (1.f / D) + EPS);
            if (m < T) { v2u* o8 = (v2u*)(U + (size_t)m * D) + lane;
#pragma unroll
                for (int j = 0; j < 4; ++j) { const f32x4 y = v[i][j] * rstd * g[j]; v2u w; w.x = cvt_pk_bf16(y.x, y.y); w.y = cvt_pk_bf16(y.z, y.w); o8[64 * j] = w; } } }
    }
    for (int m = gw; m < 256; m += NGW) {
        bf16* orow = U + (size_t)(T + m) * D;
        if (m >= META_PAD && m < META_PAD + 16) rms_row_to_bf16(P.meta + (size_t)(m - META_PAD) * D, g, orow, lane);
        else { v4u z = {0u, 0u, 0u, 0u}; ((v4u*)orow)[lane] = z; ((v4u*)orow)[lane + 64] = z; }
    }
}

constexpr int RS = 72;
__device__ __forceinline__ bf16x8 ldsv(const LAS bf16* p) { return *(const LAS bf16x8*)p; }
__device__ __forceinline__ void gla_item(LAS unsigned char* lds, int item, const bf16* Qg, const bf16* Kg, const bf16* Vg, const bf16* Rg, const float* LAg, const float* gn, bf16* ON, int tid) {
    const int b = item >> 2, h = item & 3;
    const int w = __builtin_amdgcn_readfirstlane(tid >> 6), lane = tid & 63, fr = lane & 15, fq = lane >> 4;
    LAS bf16* sQp = (LAS bf16*)lds; LAS bf16* sQm = sQp + 64 * RS; LAS bf16* sKm = sQm + 64 * RS; LAS bf16* sKp = sKm + 64 * RS; LAS bf16* sKeT = sKp + 64 * RS;
    LAS bf16* sVT = sKeT + 64 * RS; LAS bf16* sP = sVT + 128 * RS; LAS bf16* sST = sP + 64 * RS; LAS float* sD = (LAS float*)(sST + 128 * RS); LAS float* sSsq = sD + 64;
    const int tt = w & 3, vh = w >> 2;
    f32x4 Sacc[4], gnr[4];
#pragma unroll
    for (int j = 0; j < 4; ++j) { Sacc[j] = (f32x4){0.f, 0.f, 0.f, 0.f}; gnr[j] = *(const f32x4*)(gn + h * 128 + 64 * vh + 16 * j + 4 * fq); }
    v4u q8, k8, v16a, v16b; f32x4 la0, la1;
#ifdef EXP_NO_META
    for (int i = tid; i < 128 * RS / 2; i += NTHR) ((LAS unsigned*)sST)[i] = 0u;
    __syncthreads();
#endif
#define GLA_LOAD(c) do { const size_t row = ((c) == 0 ? (size_t)T : (size_t)b * SEQ + (size_t)((c) - 1) * 64) + lane; \
        q8 = *(const v4u*)(Qg + row * 256 + h * 64 + 8 * w); k8 = *(const v4u*)(Kg + row * 256 + h * 64 + 8 * w); \
        la0 = *(const f32x4*)(LAg + row * 256 + h * 64 + 8 * w); la1 = *(const f32x4*)(LAg + row * 256 + h * 64 + 8 * w + 4); \
        v16a = *(const v4u*)(Vg + row * 512 + h * 128 + 16 * w); v16b = *(const v4u*)(Vg + row * 512 + h * 128 + 16 * w + 8); } while (0)
#ifdef EXP_NO_META
    GLA_LOAD(1);
    for (int c = 1; c <= NCHUNK; ++c) {
#else
    GLA_LOAD(0);
    v2u ysave[4]; size_t orow_prev = 0;
    for (int c = 0; c <= NCHUNK; ++c) {
#endif
        float bc[8] = {la0.x, la0.y, la0.z, la0.w, la1.x, la1.y, la1.z, la1.w};
        if (c == 0 && lane < META_PAD) {
#pragma unroll
            for (int i = 0; i < 8; ++i) bc[i] = 0.f; }
#pragma unroll
        for (int i = 0; i < 8; ++i) {
#pragma unroll
            for (int d = 1; d < 64; d <<= 1) { const float n = __shfl_up(bc[i], d); if (lane >= d) bc[i] += n; } }
        float qf[8] = {bf_lo(q8.x), bf_hi(q8.x), bf_lo(q8.y), bf_hi(q8.y), bf_lo(q8.z), bf_hi(q8.z), bf_lo(q8.w), bf_hi(q8.w)};
        float kf[8] = {bf_lo(k8.x), bf_hi(k8.x), bf_lo(k8.y), bf_hi(k8.y), bf_lo(k8.z), bf_hi(k8.z), bf_lo(k8.w), bf_hi(k8.w)};
        float qp[8], qm[8], km[8], kp[8], ke[8], dd[8];
#pragma unroll
        for (int i = 0; i < 8; ++i) { const float be = __shfl(bc[i], 63); const float eb = __expf(bc[i]), emb = __expf(-bc[i]), ek = __expf(be - bc[i]);
            qp[i] = qf[i] * eb; qm[i] = qf[i] * emb; km[i] = kf[i] * emb; kp[i] = kf[i] * eb; ke[i] = kf[i] * ek; dd[i] = __expf(be); }
        {
            v4u o;
            o.x = cvt_pk_bf16(qp[0], qp[1]); o.y = cvt_pk_bf16(qp[2], qp[3]); o.z = cvt_pk_bf16(qp[4], qp[5]); o.w = cvt_pk_bf16(qp[6], qp[7]); *(LAS v4u*)(sQp + lane * RS + 8 * w) = o;
            o.x = cvt_pk_bf16(qm[0], qm[1]); o.y = cvt_pk_bf16(qm[2], qm[3]); o.z = cvt_pk_bf16(qm[4], qm[5]); o.w = cvt_pk_bf16(qm[6], qm[7]); *(LAS v4u*)(sQm + lane * RS + 8 * w) = o;
            o.x = cvt_pk_bf16(km[0], km[1]); o.y = cvt_pk_bf16(km[2], km[3]); o.z = cvt_pk_bf16(km[4], km[5]); o.w = cvt_pk_bf16(km[6], km[7]); *(LAS v4u*)(sKm + lane * RS + 8 * w) = o;
            o.x = cvt_pk_bf16(kp[0], kp[1]); o.y = cvt_pk_bf16(kp[2], kp[3]); o.z = cvt_pk_bf16(kp[4], kp[5]); o.w = cvt_pk_bf16(kp[6], kp[7]); *(LAS v4u*)(sKp + lane * RS + 8 * w) = o;
        }
#pragma unroll
        for (int i = 0; i < 8; i += 2) { const unsigned pk = cvt_pk_bf16(ke[i], ke[i + 1]); sKeT[(8 * w + i) * RS + lane] = (bf16)(pk & 0xffffu); sKeT[(8 * w + i + 1) * RS + lane] = (bf16)(pk >> 16); }
        {
            const unsigned vv[8] = {v16a.x, v16a.y, v16a.z, v16a.w, v16b.x, v16b.y, v16b.z, v16b.w};
#pragma unroll
            for (int i = 0; i < 8; ++i) { sVT[(16 * w + 2 * i) * RS + lane] = (bf16)(vv[i] & 0xffffu); sVT[(16 * w + 2 * i + 1) * RS + lane] = (bf16)(vv[i] >> 16); }
        }
        if (lane == 0) {
#pragma unroll
            for (int i = 0; i < 8; ++i) sD[8 * w + i] = dd[i]; }
        if (c > 1) {
#pragma unroll
            for (int j = 0; j < 4; ++j) *(v2u*)(ON + orow_prev * 512 + h * 128 + 64 * vh + 16 * j + 4 * fq) = ysave[j]; }
        const int cn = (c < NCHUNK) ? c + 1 : c;
        GLA_LOAD(cn);
        v2u rr[4];
        const size_t orow = (size_t)b * SEQ + (size_t)(c > 0 ? c - 1 : 0) * 64 + 16 * tt + fr;
#pragma unroll
        for (int j = 0; j < 4; ++j) rr[j] = *(const v2u*)(Rg + orow * 512 + h * 128 + 64 * vh + 16 * j + 4 * fq);
        __syncthreads();
        f32x4 oacc[4];
#pragma unroll
        for (int j = 0; j < 4; ++j) oacc[j] = (f32x4){0.f, 0.f, 0.f, 0.f};
        if (c > 0) {
            const int st_t = w >> 1;
#pragma unroll
            for (int s2 = 0; s2 < 2; ++s2) { const int st = 2 * (w & 1) + s2; f32x4 a1 = {0.f, 0.f, 0.f, 0.f}, a2 = {0.f, 0.f, 0.f, 0.f};
                if (st <= st_t) {
#pragma unroll
                    for (int kk = 0; kk < 2; ++kk) a1 = __builtin_amdgcn_mfma_f32_16x16x32_bf16(ldsv(sKm + (16 * st + fr) * RS + 32 * kk + 8 * fq), ldsv(sQp + (16 * st_t + fr) * RS + 32 * kk + 8 * fq), a1, 0, 0, 0); }
                if (st >= st_t) {
#pragma unroll
                    for (int kk = 0; kk < 2; ++kk) a2 = __builtin_amdgcn_mfma_f32_16x16x32_bf16(ldsv(sKp + (16 * st + fr) * RS + 32 * kk + 8 * fq), ldsv(sQm + (16 * st_t + fr) * RS + 32 * kk + 8 * fq), a2, 0, 0, 0); }
                const int t = 16 * st_t + fr, s0 = 16 * st + 4 * fq; float p[4];
#pragma unroll
                for (int i = 0; i < 4; ++i) p[i] = (s0 + i <= t) ? a1[i] : a2[i];
                v2u o; o.x = cvt_pk_bf16(p[0], p[1]); o.y = cvt_pk_bf16(p[2], p[3]); *(LAS v2u*)(sP + t * RS + s0) = o; }
            {
                bf16x8 fs[4][2], fq2[2];
#pragma unroll
                for (int kk = 0; kk < 2; ++kk) fq2[kk] = ldsv(sQp + (16 * tt + fr) * RS + 32 * kk + 8 * fq);
#pragma unroll
                for (int j = 0; j < 4; ++j)
#pragma unroll
                    for (int kk = 0; kk < 2; ++kk) fs[j][kk] = ldsv(sST + (16 * (4 * vh + j) + fr) * RS + 32 * kk + 8 * fq);
#pragma unroll
                for (int j = 0; j < 4; ++j)
#pragma unroll
                    for (int kk = 0; kk < 2; ++kk) oacc[j] = __builtin_amdgcn_mfma_f32_16x16x32_bf16(fs[j][kk], fq2[kk], oacc[j], 0, 0, 0);
            }
        }
        __syncthreads();
        {
            bf16x8 fv[4][2], fp[2], fk[2];
#pragma unroll
            for (int j = 0; j < 4; ++j)
#pragma unroll
                for (int kk = 0; kk < 2; ++kk) fv[j][kk] = ldsv(sVT + (16 * (4 * vh + j) + fr) * RS + 32 * kk + 8 * fq);
#pragma unroll
            for (int kk = 0; kk < 2; ++kk) { fk[kk] = ldsv(sKeT + (16 * tt + fr) * RS + 32 * kk + 8 * fq); fp[kk] = ldsv(sP + (16 * tt + fr) * RS + 32 * kk + 8 * fq); }
            const f32x4 dv = *(const LAS f32x4*)(sD + 16 * tt + 4 * fq);
            if (c > 0) {
#pragma unroll
                for (int j = 0; j < 4; ++j)
#pragma unroll
                    for (int kk = 0; kk < 2; ++kk) oacc[j] = __builtin_amdgcn_mfma_f32_16x16x32_bf16(fv[j][kk], fp[kk], oacc[j], 0, 0, 0);
            }
#pragma unroll
            for (int j = 0; j < 4; ++j) { Sacc[j] = Sacc[j] * dv;
#pragma unroll
                for (int kk = 0; kk < 2; ++kk) Sacc[j] = __builtin_amdgcn_mfma_f32_16x16x32_bf16(fk[kk], fv[j][kk], Sacc[j], 0, 0, 0); }
#pragma unroll
            for (int j = 0; j < 4; ++j) { v2u o; o.x = cvt_pk_bf16(Sacc[j][0], Sacc[j][1]); o.y = cvt_pk_bf16(Sacc[j][2], Sacc[j][3]); *(LAS v2u*)(sST + (16 * (4 * vh + j) + fr) * RS + 16 * tt + 4 * fq) = o; }
        }
        float ss = 0.f;
#pragma unroll
        for (int j = 0; j < 4; ++j) ss += (oacc[j][0] * oacc[j][0] + oacc[j][1] * oacc[j][1]) + (oacc[j][2] * oacc[j][2] + oacc[j][3] * oacc[j][3]);
        ss += __shfl_xor(ss, 16); ss += __shfl_xor(ss, 32);
        if (fq == 0) sSsq[(16 * tt + fr) * 2 + vh] = ss;
        __syncthreads();
        if (c > 0) {
            const float tot = sSsq[(16 * tt + fr) * 2] + sSsq[(16 * tt + fr) * 2 + 1];
            const float rstd = __builtin_amdgcn_rsqf(tot * (1.0f / 128.0f) + EPS);
#pragma unroll
            for (int j = 0; j < 4; ++j) { const f32x4 rv = {bf_lo(rr[j].x), bf_hi(rr[j].x), bf_lo(rr[j].y), bf_hi(rr[j].y)}; const f32x4 y = oacc[j] * rstd * gnr[j] * rv;
                ysave[j].x = cvt_pk_bf16(y[0], y[1]); ysave[j].y = cvt_pk_bf16(y[2], y[3]); }
            orow_prev = orow;
        }
    }
#pragma unroll
    for (int j = 0; j < 4; ++j) *(v2u*)(ON + orow_prev * 512 + h * 128 + 64 * vh + 16 * j + 4 * fq) = ysave[j];
#undef GLA_LOAD
    __syncthreads();
}
__device__ __forceinline__ void pool_task(int task, const bf16* Ab, bf16* PA, int tid) {
    const int wave = tid >> 6, lane = tid & 63, b = task >> 3, i0 = (task & 7) * 256 + wave * 32;
    const int wd = 2 << (lane >> 4); const float inv = 1.0f / (float)wd;
    float sum[8];
#pragma unroll
    for (int e = 0; e < 8; ++e) sum[e] = 0.f;
#define AROW(i) ((i) >= 0 ? (size_t)b * SEQ + (size_t)(i) : (size_t)(T + 64 + (i)))
#define UNPK(w8, f) { f[0] = bf_lo(w8.x); f[1] = bf_hi(w8.x); f[2] = bf_lo(w8.y); f[3] = bf_hi(w8.y); f[4] = bf_lo(w8.z); f[5] = bf_hi(w8.z); f[6] = bf_lo(w8.w); f[7] = bf_hi(w8.w); }
    {
        v4u wv[15];
#pragma unroll
        for (int d = 1; d < 16; ++d) { const v4u z = {0u, 0u, 0u, 0u}; wv[d - 1] = (d < wd) ? *(const v4u*)(Ab + AROW(i0 - d) * 512 + 8 * lane) : z; }
#pragma unroll
        for (int d = 1; d < 16; ++d) { float f[8]; UNPK(wv[d - 1], f);
#pragma unroll
            for (int e = 0; e < 8; ++e) sum[e] += f[e]; }
    }
    for (int i4 = i0; i4 < i0 + 32; i4 += 4) {
        v4u c8[4], o8[4];
#pragma unroll
        for (int q = 0; q < 4; ++q) { c8[q] = *(const v4u*)(Ab + AROW(i4 + q) * 512 + 8 * lane); o8[q] = *(const v4u*)(Ab + AROW(i4 + q - wd + 1) * 512 + 8 * lane); }
#pragma unroll
        for (int q = 0; q < 4; ++q) { float cf[8], of[8], y[8]; UNPK(c8[q], cf); UNPK(o8[q], of);
#pragma unroll
            for (int e = 0; e < 8; ++e) { sum[e] += cf[e]; y[e] = sum[e] * inv - cf[e]; sum[e] -= of[e]; }
            v4u o; o.x = cvt_pk_bf16(y[0], y[1]); o.y = cvt_pk_bf16(y[2], y[3]); o.z = cvt_pk_bf16(y[4], y[5]); o.w = cvt_pk_bf16(y[6], y[7]);
            *(v4u*)(PA + ((size_t)b * SEQ + i4 + q) * 512 + 8 * lane) = o; }
    }
#undef AROW
#undef UNPK
}

#define XB_TMO      128
#define XB_XCNT(j)  (256  + 64 * (j))
#define XB_XSUB(j)  (1280 + 64 * (j))
#define XB_XGEN(j)  (2304 + 64 * (j))
#define XB_TOP      3328
#define XB_TOPGEN   3392
#define XCD_BAR_WORDS 3456
#define XB_SPIN_CAP (1u << 18)

__device__ __forceinline__ unsigned xb_ld(unsigned* p)              { return __hip_atomic_load(p, __ATOMIC_RELAXED, __HIP_MEMORY_SCOPE_AGENT); }
__device__ __forceinline__ unsigned xb_add(unsigned* p, unsigned v) { return __hip_atomic_fetch_add(p, v, __ATOMIC_RELAXED, __HIP_MEMORY_SCOPE_AGENT); }
__device__ __forceinline__ unsigned xb_xcc_id() { return (unsigned)__builtin_amdgcn_s_getreg((3 << 11) | 20) & 0xFu; }
#define XB_SPIN(cond, bar) do { unsigned _sp = 0; while (cond) { __builtin_amdgcn_s_sleep(1); \
    if ((++_sp & 255u) == 0u) { if (xb_ld(&(bar)[XB_TMO])) break; if (_sp > XB_SPIN_CAP) { atomicAdd(&(bar)[XB_TMO], 1u); break; } } } } while (0)

struct XcdBarrier {
    unsigned* bar; unsigned x;
    volatile LAS unsigned* st;
};

__device__ __forceinline__ XcdBarrier xcd_barrier_post(unsigned* bar, volatile LAS unsigned* st) {
    XcdBarrier b; b.bar = bar; b.x = xb_xcc_id(); b.st = st;
    if (threadIdx.x == 0) (void)xb_add(&bar[XB_XCNT(b.x)], 1u);
    return b;
}
__device__ __forceinline__ void xcd_barrier_complete(unsigned* bar, unsigned x, unsigned& nloc, unsigned& nx) {
    const unsigned G = gridDim.x * gridDim.y * gridDim.z;
    unsigned sum, cnt, mine, sp = 0u;
    for (;;) {
        sum = 0u; cnt = 0u; mine = 0u;
#pragma unroll
        for (unsigned j = 0; j < 16; ++j) { const unsigned c = xb_ld(&bar[XB_XCNT(j)]); sum += c; cnt += (c > 0u) ? 1u : 0u; mine = (j == x) ? c : mine; }
        if (sum == G) break;
        __builtin_amdgcn_s_sleep(1);
        if ((++sp & 255u) == 0u) { if (xb_ld(&bar[XB_TMO])) break; if (sp > XB_SPIN_CAP) { atomicAdd(&bar[XB_TMO], 1u); break; } }
    }
    nloc = mine > 0u ? mine : 1u; nx = cnt > 0u ? cnt : 1u;
}

__device__ __forceinline__ void xcd_barrier(const XcdBarrier& b) {
    asm volatile("s_waitcnt vmcnt(0)" ::: "memory");
    __syncthreads();
    if (threadIdx.x == 0) {
        unsigned* bar = b.bar;
        __builtin_amdgcn_s_waitcnt(0);
        unsigned nloc = b.st[0], nx = b.st[1];
        if (nloc == 0u) { xcd_barrier_complete(bar, b.x, nloc, nx); b.st[0] = nloc; b.st[1] = nx; }
        const unsigned old = xb_add(&bar[XB_XSUB(b.x)], 1u);
        const unsigned gen = old / nloc;
        if (old + 1u == (gen + 1u) * nloc) {
            __builtin_amdgcn_fence(__ATOMIC_RELEASE, "agent");
            asm volatile("s_waitcnt vmcnt(0)" ::: "memory");
            const unsigned og = xb_add(&bar[XB_TOP], 1u);
            const unsigned tg = og / nx;
            if (og + 1u == (tg + 1u) * nx) xb_add(&bar[XB_TOPGEN], 1u);
            else XB_SPIN(xb_ld(&bar[XB_TOPGEN]) == tg, bar);
            __builtin_amdgcn_fence(__ATOMIC_ACQUIRE, "agent");
            xb_add(&bar[XB_XGEN(b.x)], 1u);
            asm volatile("s_waitcnt vmcnt(0)" ::: "memory");
        } else {
            XB_SPIN(xb_ld(&bar[XB_XGEN(b.x)]) == gen, bar);
            __builtin_amdgcn_fence(__ATOMIC_ACQUIRE, "agent");
            asm volatile("s_waitcnt vmcnt(0)" ::: "memory");
        }
    }
    __syncthreads();
}

#define WSP(T_, off) ((T_*)(P.ws + (off)))
#ifndef STAGGER_TICKS
#define STAGGER_TICKS 0
#endif
__device__ __forceinline__ void stagger(const pg8::StaticOrder& S) {
    if (STAGGER_TICKS <= 0) return;
    pg8::Unit u0; if (!S.next(0, u0)) return;
    const unsigned long long t0 = __builtin_amdgcn_s_memrealtime();
    const unsigned long long wait = (unsigned long long)(u0.pm & 7) * STAGGER_TICKS;
    while (__builtin_amdgcn_s_memrealtime() - t0 < wait) __builtin_amdgcn_s_sleep(4);
}
__device__ __forceinline__ void phase_1(const Ptrs& P, LAS unsigned char* lds, int tid, int G) {
    pg8::Gemm g{WSP(bf16, WS_U), WSP(bf16, WS_WIN), TP, NZ, D}; pg8::StaticOrder S; S.init(TP, NZ, G, (int)blockIdx.x); stagger(S);
    pg8::EpiZ E{WSP(bf16, WS_A), WSP(bf16, WS_Q), WSP(bf16, WS_K), WSP(bf16, WS_V), WSP(bf16, WS_R), WSP(float, WS_LA), WSP(bf16, WS_GA), WSP(bf16, WS_GB), P.b_gate};
    pg8::gemm_phase<pg8::EpiZ, pg8::StaticOrder, PG8_ALIGN, PG8_SP2>(lds, g, S, E);
}
__device__ __forceinline__ void phase_2(const Ptrs& P, LAS unsigned char* lds, int tid, int G) {
    for (int item = blockIdx.x; item < BATCH * 4; item += G) gla_item(lds, item, WSP(bf16, WS_Q), WSP(bf16, WS_K), WSP(bf16, WS_V), WSP(bf16, WS_R), WSP(float, WS_LA), P.gla_norm, WSP(bf16, WS_ON), tid);
    if (G > 128) { for (int task = (int)blockIdx.x - 128; task >= 0 && task < 256; task += G - 128) pool_task(task, WSP(bf16, WS_A), WSP(bf16, WS_PA), tid); }
    else { for (int task = blockIdx.x; task < 256; task += G) pool_task(task, WSP(bf16, WS_A), WSP(bf16, WS_PA), tid); }
}
__device__ __forceinline__ void phase_3(const Ptrs& P, LAS unsigned char* lds, int tid, int G) {
    pg8::Gemm g{WSP(bf16, WS_PA), WSP(bf16, WS_WA), T, D, 512}; pg8::StaticOrder S; S.init(T, D, G, (int)blockIdx.x); stagger(S);
    pg8::EpiGate<false> E{WSP(bf16, WS_GA), WSP(bf16, WS_U)};
    pg8::gemm_phase<pg8::EpiGate<false>, pg8::StaticOrder, PG8_ALIGN, PG8_SP2>(lds, g, S, E);
}
__device__ __forceinline__ void phase_4(const Ptrs& P, LAS unsigned char* lds, int tid, int G) {
    pg8::Gemm g{WSP(bf16, WS_ON), WSP(bf16, WS_WB), T, D, 512}; pg8::StaticOrder S; S.init(T, D, G, (int)blockIdx.x); stagger(S);
    pg8::EpiGate<true> E{WSP(bf16, WS_GB), WSP(bf16, WS_U)};
    pg8::gemm_phase<pg8::EpiGate<true>, pg8::StaticOrder, PG8_ALIGN, PG8_SP2>(lds, g, S, E);
}
__device__ __forceinline__ void phase_5(const Ptrs& P, LAS unsigned char* lds, int tid, int G) {
    pg8::Gemm g{WSP(bf16, WS_U), WSP(bf16, WS_WO), T, D, D}; pg8::StaticOrder S; S.init(T, D, G, (int)blockIdx.x); stagger(S);
    pg8::EpiOut E{P.x, WSP(bf16, WS_U2), WSP(float, WS_SSQ)};
    pg8::gemm_phase<pg8::EpiOut, pg8::StaticOrder, PG8_ALIGN, PG8_SP2>(lds, g, S, E);
}
__device__ __forceinline__ void phase_6(const Ptrs& P, LAS unsigned char* lds, int tid, int G, int skip = 0) {
    pg8::Gemm g{WSP(bf16, WS_U2), WSP(bf16, WS_W1), T, FF, D}; pg8::StaticOrder S; S.init(T, FF, G, (int)blockIdx.x); stagger(S);
    pg8::EpiFF1 E{WSP(float, WS_SSQ), WSP(bf16, WS_HD), skip};
    pg8::gemm_phase<pg8::EpiFF1, pg8::StaticOrder, PG8_ALIGN, PG8_SP2>(lds, g, S, E);
}
__device__ __forceinline__ void phase_7(const Ptrs& P, LAS unsigned char* lds, int tid, int G) {
    pg8::Gemm g{WSP(bf16, WS_HD), WSP(bf16, WS_W2), T, D, FF}; pg8::StaticOrder S; S.init(T, D, G, (int)blockIdx.x); stagger(S);
    pg8::EpiFF2 E{WSP(bf16, WS_U2), WSP(bf16, WS_U)};
    pg8::gemm_phase<pg8::EpiFF2, pg8::StaticOrder, PG8_ALIGN, PG8_SP2>(lds, g, S, E);
}
__device__ __forceinline__ void phase_8(const Ptrs& P, LAS unsigned char* lds, int tid, int G) {
    const int lane = tid & 63, gw = blockIdx.x * NWAVES + (tid >> 6), NGW = G * NWAVES;
    const bf16* H2 = WSP(bf16, WS_U);
    f32x4 g[2][2];
#pragma unroll
    for (int q = 0; q < 2; ++q)
#pragma unroll
        for (int n = 0; n < 2; ++n) g[q][n] = *(const f32x4*)(P.norm_final + 512 * q + 8 * lane + 4 * n);
    for (int m0 = gw; m0 < T; m0 += 8 * NGW) {
        v4u hv[8][2];
#pragma unroll
        for (int i = 0; i < 8; ++i) { const int m = m0 + i * NGW; const v4u* hr = (const v4u*)(H2 + (size_t)(m < T ? m : m0) * D) + lane; hv[i][0] = hr[0]; hv[i][1] = hr[64]; }
#pragma unroll
        for (int i = 0; i < 8; ++i) { const int m = m0 + i * NGW; f32x4 v[2][2]; float s = 0.f;
#pragma unroll
            for (int q = 0; q < 2; ++q) { const v4u t = hv[i][q]; v[q][0] = (f32x4){bf_lo(t.x), bf_hi(t.x), bf_lo(t.y), bf_hi(t.y)}; v[q][1] = (f32x4){bf_lo(t.z), bf_hi(t.z), bf_lo(t.w), bf_hi(t.w)};
#pragma unroll
                for (int n = 0; n < 2; ++n) s += (v[q][n].x * v[q][n].x + v[q][n].y * v[q][n].y) + (v[q][n].z * v[q][n].z + v[q][n].w * v[q][n].w); }
            const float rstd = __builtin_amdgcn_rsqf(wave_sum(s) * (1.f / D) + EPS);
            if (m < T) { float* xo = P.out + (size_t)m * D + 8 * lane;
#pragma unroll
                for (int q = 0; q < 2; ++q)
#pragma unroll
                    for (int n = 0; n < 2; ++n) *(f32x4*)(xo + 512 * q + 4 * n) = v[q][n] * rstd * g[q][n]; } }
    }
}
__device__ __forceinline__ void phase_0(const Ptrs& P, LAS unsigned char* lds, int tid, int G) { p0_prologue(P, lds, tid, G); __syncthreads(); }

struct Args { Ptrs p; int ph_lo, ph_hi, coop, pad; };
__global__ void __launch_bounds__(NTHR, 2) hybrid_fwd(Args args) {
    extern __shared__ __attribute__((aligned(16))) unsigned char lds_raw[];
    cg::grid_group grid = cg::this_grid();
    LAS unsigned char* lds = (LAS unsigned char*)lds_raw;
    const Ptrs& P = args.p;
    const int tid = threadIdx.x, G = gridDim.x, lo = args.ph_lo, hi = args.ph_hi;
    volatile LAS unsigned* bst = (volatile LAS unsigned*)(lds + 131072);
    if (tid < 2) bst[tid] = 0u;
    __syncthreads();
    XcdBarrier bar; bar.bar = (unsigned*)(P.ws + WS_CTL); bar.x = 0; bar.st = bst;
    if (args.coop == 1) bar = xcd_barrier_post((unsigned*)(P.ws + WS_CTL), bst);
#define GSYNC() do { if (args.coop == 1) xcd_barrier(bar); else grid.sync(); } while (0)
#define IN(k) (lo <= (k) && (k) < hi)
#define SEAM(k) do { if (IN(k) && IN((k) + 1)) GSYNC(); } while (0)
#define DUP(k, body) do { if ((PROBE_DUP >> (k)) & 1) { GSYNC(); body; } } while (0)
    if (IN(0)) phase_0(P, lds, tid, G);
    DUP(0, phase_0(P, lds, tid, G));
    SEAM(0);
    if (IN(1)) phase_1(P, lds, tid, G);
    DUP(1, phase_1(P, lds, tid, G));
    SEAM(1);
    if (IN(2)) phase_2(P, lds, tid, G);
    DUP(2, phase_2(P, lds, tid, G));
    SEAM(2);
    if (IN(3)) phase_3(P, lds, tid, G);
    DUP(3, phase_3(P, lds, tid, G));
    SEAM(3);
    if (IN(4)) phase_4(P, lds, tid, G);
    DUP(4, { phase_3(P, lds, tid, G); GSYNC(); phase_4(P, lds, tid, G); });
    SEAM(4);
    if (IN(5)) phase_5(P, lds, tid, G);
    DUP(5, phase_5(P, lds, tid, G));
    SEAM(5);
    if (IN(6)) phase_6(P, lds, tid, G);
    DUP(6, phase_6(P, lds, tid, G, 1));
    SEAM(6);
    if (IN(7)) phase_7(P, lds, tid, G);
    DUP(7, { phase_5(P, lds, tid, G); GSYNC(); phase_7(P, lds, tid, G); });
    SEAM(7);
    if (IN(8)) phase_8(P, lds, tid, G);
#undef IN
#undef SEAM
#undef DUP
}

constexpr int N_PHASES = 9;
extern "C" void kernel_launch(void* const* d_in, const int* in_sizes, int n_in, void* d_out, int out_size, void* d_ws, size_t ws_size, hipStream_t stream) {
    static int grid = 0;
    if (grid == 0) {
        if (n_in != 16 || in_sizes[0] != T * D || out_size != T * D || ws_size < WS_END) { fprintf(stderr, "kernel_launch: unexpected shapes (n_in %d in0 %d out %d ws %zu)\n", n_in, n_in > 0 ? in_sizes[0] : -1, out_size, ws_size); grid = -1; return; }
        int dev = 0, cus = 0, per_cu = 0;
        hipGetDevice(&dev); hipDeviceGetAttribute(&cus, hipDeviceAttributeMultiprocessorCount, dev);
        if (hipFuncSetAttribute((const void*)hybrid_fwd, hipFuncAttributeMaxDynamicSharedMemorySize, LDS_BYTES) != hipSuccess) { fprintf(stderr, "kernel_launch: hipFuncSetAttribute failed\n"); grid = -1; return; }
        if (hipOccupancyMaxActiveBlocksPerMultiprocessor(&per_cu, (const void*)hybrid_fwd, NTHR, LDS_BYTES) != hipSuccess || per_cu < 1) { fprintf(stderr, "kernel_launch: occupancy query says %d\n", per_cu); per_cu = 1; }
        (void)hipGetLastError();
        grid = cus * 1;
        if (grid <= 0) grid = 256;
    }
    if (grid < 0) return;
    Args a{};
    Ptrs& p = a.p;
    p.x = (const float*)d_in[0]; p.meta = (const float*)d_in[1]; p.norm_mix = (const float*)d_in[2]; p.w_in = (const float*)d_in[3]; p.w_pool_mix = (const float*)d_in[4];
    p.pool_scale = (const float*)d_in[5]; p.w_pool_out = (const float*)d_in[6]; p.w_gate_up = (const float*)d_in[7]; p.b_gate = (const float*)d_in[8]; p.gla_norm = (const float*)d_in[9];
    p.w_gla_out = (const float*)d_in[10]; p.w_out = (const float*)d_in[11]; p.norm_ffn = (const float*)d_in[12]; p.w_ff1 = (const float*)d_in[13]; p.w_ff2 = (const float*)d_in[14];
    p.norm_final = (const float*)d_in[15]; p.out = (float*)d_out; p.ws = (unsigned char*)d_ws;
#if MK_N_LAUNCHES == 1
    if (hipMemsetAsync((char*)d_ws + WS_CTL, 0, CTL_BYTES, stream) != hipSuccess) { fprintf(stderr, "kernel_launch: memset of the barrier words failed\n"); return; }
    a.ph_lo = 0; a.ph_hi = N_PHASES; a.coop = 1;
    void* kargs[] = {&a};
    hipError_t e = hipLaunchCooperativeKernel((const void*)hybrid_fwd, dim3(grid), dim3(NTHR), kargs, LDS_BYTES, stream);
    if (e != hipSuccess) fprintf(stderr, "kernel_launch: cooperative launch failed: %s (grid %d)\n", hipGetErrorString(e), grid);
#else
    for (int ph = 0; ph < N_PHASES; ++ph) { a.ph_lo = ph; a.ph_hi = ph + 1; a.coop = 0;
        hipLaunchKernelGGL(hybrid_fwd, dim3(grid), dim3(NTHR), LDS_BYTES, stream, a); }
#endif
}
```

```cpp
#include <hip/hip_runtime.h>
#include <hip/hip_cooperative_groups.h>
#include <cstdio>
#include <cstdint>
namespace cg = cooperative_groups;

#ifndef PROBE_DUP
#define PROBE_DUP 0
#endif
#ifndef MK_N_LAUNCHES
#define MK_N_LAUNCHES 1
#endif

namespace pg8 {
#define PG8_LAS __attribute__((address_space(3)))
typedef unsigned short bf16_t;
typedef short bf16x8 __attribute__((ext_vector_type(8)));
typedef float f32x4 __attribute__((ext_vector_type(4)));
typedef unsigned u32x4 __attribute__((ext_vector_type(4)));
constexpr int BM = 256, BK = 64, HALF = 128, HTB = HALF * BK * 2  , STAGE_BYTES = 8 * HTB, NXCD = 8, WGM = 8;

__host__ __device__ __forceinline__ int lds_byte(int r, int c) { const int st = (r >> 4) * 2 + (c >> 5), rr = r & 15, cc = c & 31, ob = rr * 64 + cc * 2; return st * 1024 + (ob ^ (((ob >> 9) & 1) << 5)); }
__host__ __device__ __forceinline__ void stage_rc(int b, int& R, int& C) { const int st = b / 1024, sb = b % 1024, swz = sb ^ (((sb >> 9) & 1) << 5); R = (st >> 1) * 16 + swz / 64; C = (st & 1) * 32 + (swz % 64) / 2; }
__host__ __device__ __forceinline__ int perm32(int rho) { const int n = rho >> 4, i = rho & 15; return 8 * (i >> 2) + 4 * n + (i & 3); }

struct Unit { int pm, pn; };
struct Gemm { const bf16_t* A; const bf16_t* Bt; int M, N, K; };

struct StaticOrder {
    int nM, nN, nwg, G, c;
    __host__ __device__ void init(int M, int N, int G_, int c_) { nM = M / BM; nN = N / BM; nwg = nM * nN; G = G_; c = c_; }
    __host__ __device__ bool next(int i, Unit& u) const {
        const long L = (long)i * G + c; if (L >= nwg) return false;
        int wgid = (int)L; { const int q = nwg / NXCD, r = nwg % NXCD, xcd = wgid % NXCD, off = wgid / NXCD; wgid = (xcd < r ? xcd * (q + 1) : r * (q + 1) + (xcd - r) * q) + off; }
        const int nig = WGM * nN, gid = wgid / nig, fm = gid * WGM, gsz = (nM - fm) < WGM ? (nM - fm) : WGM;
        u.pm = fm + ((wgid % nig) % gsz); u.pn = (wgid % nig) / gsz; return true;
    }
    __device__ __forceinline__ void a_ready(const Unit&) const {}
    __device__ __forceinline__ void done(const Unit&) const {}
};

typedef float f32x2_t __attribute__((ext_vector_type(2))); typedef __bf16 bf16x2_t __attribute__((ext_vector_type(2)));
__device__ __forceinline__ unsigned cvt_pk_bf16(float lo, float hi) { f32x2_t v = {lo, hi}; bf16x2_t b = __builtin_convertvector(v, bf16x2_t); return __builtin_bit_cast(unsigned, b); }
struct PanelOrder {
    int p0, p1;
    __host__ __device__ bool next(int i, Unit& u) const { if (i >= 8) return false; u.pm = (i < 4) ? p0 : p1; u.pn = i & 3; return true; }
    __device__ __forceinline__ void a_ready(const Unit&) const {}
    __device__ __forceinline__ void done(const Unit&) const {}
};
typedef unsigned u32x2 __attribute__((ext_vector_type(2)));
__device__ __forceinline__ float bf_lo(unsigned w) { return __uint_as_float(w << 16); }
__device__ __forceinline__ float bf_hi(unsigned w) { return __uint_as_float(w & 0xffff0000u); }
__device__ __forceinline__ float sigm(float v) { return __builtin_amdgcn_rcpf(1.0f + __expf(-v)); }
__device__ __forceinline__ float logsig(float v) { return fminf(v, 0.f) - __logf(1.0f + __expf(-fabsf(v))); }
__device__ __forceinline__ u32x4 pack8(f32x4 v0, f32x4 v1) { u32x4 w; w.x = cvt_pk_bf16(v0[0], v0[1]); w.y = cvt_pk_bf16(v0[2], v0[3]); w.z = cvt_pk_bf16(v1[0], v1[1]); w.w = cvt_pk_bf16(v1[2], v1[3]); return w; }

struct EpiZ {
    static constexpr bool PERM = true, AFTER_DRAIN = false;
    bf16_t* Ab; bf16_t* Qb; bf16_t* Kb; bf16_t* Vb; bf16_t* Rb; bf16_t* LAb; unsigned char* GAb; unsigned char* GBb; const float* bgate;
    static __device__ __forceinline__ unsigned q8(f32x4 v) {
        const unsigned a = (unsigned)(v[0] * 255.f + 0.5f), b = (unsigned)(v[1] * 255.f + 0.5f), c = (unsigned)(v[2] * 255.f + 0.5f), d = (unsigned)(v[3] * 255.f + 0.5f);
        return a | (b << 8) | (c << 16) | (d << 24); }
    template <int MODE> __device__ __forceinline__ void put(const f32x4 (&acc)[2][2][4][2], bf16_t* base, int ldc, int row0, int col0, f32x4 b0a = (f32x4){0.f, 0.f, 0.f, 0.f}, f32x4 b0b = (f32x4){0.f, 0.f, 0.f, 0.f}, f32x4 b1a = (f32x4){0.f, 0.f, 0.f, 0.f}, f32x4 b1b = (f32x4){0.f, 0.f, 0.f, 0.f}) const {
#pragma unroll
        for (int ai = 0; ai < 2; ++ai)
#pragma unroll
            for (int m = 0; m < 4; ++m) { bf16_t* rowp = base + (size_t)(row0 + ai * HALF + m * 16) * ldc + col0;
#pragma unroll
                for (int bj = 0; bj < 2; ++bj) { f32x4 v0 = acc[ai][bj][m][0], v1 = acc[ai][bj][m][1];
                    if (MODE == 1) { v0 = v0 * 0.125f; v1 = v1 * 0.125f; }
                    if (MODE == 2) {
#pragma unroll
                        for (int e = 0; e < 4; ++e) { v0[e] = v0[e] * sigm(v0[e]); v1[e] = v1[e] * sigm(v1[e]); } }
                    if (MODE == 4) { v0 = v0 + (bj ? b1a : b0a); v1 = v1 + (bj ? b1b : b0b);
#pragma unroll
                        for (int e = 0; e < 4; ++e) { v0[e] = logsig(v0[e]) * 0.0625f; v1[e] = logsig(v1[e]) * 0.0625f; } }
                    *(u32x4*)(rowp + bj * HALF) = pack8(v0, v1); } }
    }
    __device__ __forceinline__ void putg(const f32x4 (&acc)[2][2][4][2], unsigned char* base, int row0, int col0) const {
#pragma unroll
        for (int ai = 0; ai < 2; ++ai)
#pragma unroll
            for (int m = 0; m < 4; ++m) { unsigned char* rowp = base + (size_t)(row0 + ai * HALF + m * 16) * 1024 + col0;
#pragma unroll
                for (int bj = 0; bj < 2; ++bj) { f32x4 v0 = acc[ai][bj][m][0], v1 = acc[ai][bj][m][1];
#pragma unroll
                    for (int e = 0; e < 4; ++e) { v0[e] = sigm(v0[e]); v1[e] = sigm(v1[e]); }
                    u32x2 w; w.x = q8(v0); w.y = q8(v1); *(u32x2*)(rowp + bj * HALF) = w; } }
    }
    __device__ __forceinline__ void operator()(const f32x4 (&acc)[2][2][4][2], const Unit& u, int wr, int wc, int fr, int fq) const {
        const int pn = u.pn, row0 = u.pm * BM + wr * 64 + fr, cl = wc * 32 + 8 * fq;
        if (pn < 2) put<0>(acc, Ab, 512, row0, pn * 256 + cl);
        else if (pn == 2) put<1>(acc, Qb, 256, row0, cl);
        else if (pn == 3) put<0>(acc, Kb, 256, row0, cl);
        else if (pn < 6) put<0>(acc, Vb, 512, row0, (pn - 4) * 256 + cl);
        else if (pn < 8) put<2>(acc, Rb, 512, row0, (pn - 6) * 256 + cl);
        else if (pn == 8) put<4>(acc, LAb, 256, row0, cl, *(const f32x4*)(bgate + cl), *(const f32x4*)(bgate + cl + 4), *(const f32x4*)(bgate + cl + HALF), *(const f32x4*)(bgate + cl + HALF + 4));
        else if (pn < 13) putg(acc, GAb, row0, (pn - 9) * 256 + cl);
        else putg(acc, GBb, row0, (pn - 13) * 256 + cl);
    }
};
template <bool ADD> struct EpiGate {
    static constexpr bool PERM = true, AFTER_DRAIN = false;
    const unsigned char* G; bf16_t* O;
    static __device__ __forceinline__ f32x4 dq(unsigned w) { return (f32x4){(float)(w & 0xffu), (float)((w >> 8) & 0xffu), (float)((w >> 16) & 0xffu), (float)(w >> 24)} * (1.0f / 255.0f); }
    __device__ __forceinline__ void operator()(const f32x4 (&acc)[2][2][4][2], const Unit& u, int wr, int wc, int fr, int fq) const {
        const int row0 = u.pm * BM + wr * 64 + fr, col0 = u.pn * BM + wc * 32 + 8 * fq;
        u32x2 g[2][4][2];
#pragma unroll
        for (int ai = 0; ai < 2; ++ai)
#pragma unroll
            for (int m = 0; m < 4; ++m)
#pragma unroll
                for (int bj = 0; bj < 2; ++bj) g[ai][m][bj] = *(const u32x2*)(G + (size_t)(row0 + ai * HALF + m * 16) * 1024 + col0 + bj * HALF);
#pragma unroll
        for (int ai = 0; ai < 2; ++ai) {
            u32x4 t[4][2];
            if (ADD) {
#pragma unroll
                for (int m = 0; m < 4; ++m)
#pragma unroll
                    for (int bj = 0; bj < 2; ++bj) t[m][bj] = *(const u32x4*)(O + (size_t)(row0 + ai * HALF + m * 16) * 1024 + col0 + bj * HALF);
            }
#pragma unroll
            for (int m = 0; m < 4; ++m)
#pragma unroll
                for (int bj = 0; bj < 2; ++bj) { const u32x2 gg = g[ai][m][bj]; f32x4 v0 = acc[ai][bj][m][0] * dq(gg.x), v1 = acc[ai][bj][m][1] * dq(gg.y);
                    if (ADD) { const u32x4 tt = t[m][bj]; v0 = v0 + (f32x4){bf_lo(tt.x), bf_hi(tt.x), bf_lo(tt.y), bf_hi(tt.y)}; v1 = v1 + (f32x4){bf_lo(tt.z), bf_hi(tt.z), bf_lo(tt.w), bf_hi(tt.w)}; }
                    *(u32x4*)(O + (size_t)(row0 + ai * HALF + m * 16) * 1024 + col0 + bj * HALF) = pack8(v0, v1); }
        }
    }
};
struct EpiOut {
    static constexpr bool PERM = true, AFTER_DRAIN = false;
    const float* X; bf16_t* U2; float* ssq;
    __device__ __forceinline__ void operator()(const f32x4 (&acc)[2][2][4][2], const Unit& u, int wr, int wc, int fr, int fq) const {
        const int row0 = u.pm * BM + wr * 64 + fr, col0 = u.pn * BM + wc * 32 + 8 * fq;
#pragma unroll
        for (int ai = 0; ai < 2; ++ai) {
            f32x4 xv[4][2][2];
#pragma unroll
            for (int m = 0; m < 4; ++m)
#pragma unroll
                for (int bj = 0; bj < 2; ++bj) { const size_t ro = (size_t)(row0 + ai * HALF + m * 16) * 1024 + col0 + bj * HALF; xv[m][bj][0] = *(const f32x4*)(X + ro); xv[m][bj][1] = *(const f32x4*)(X + ro + 4); }
#pragma unroll
            for (int m = 0; m < 4; ++m) { const int row = row0 + ai * HALF + m * 16; const size_t ro = (size_t)row * 1024 + col0; float s = 0.f;
#pragma unroll
                for (int bj = 0; bj < 2; ++bj) { const f32x4 h0 = xv[m][bj][0] + acc[ai][bj][m][0], h1 = xv[m][bj][1] + acc[ai][bj][m][1];
                    s += (h0[0] * h0[0] + h0[1] * h0[1]) + (h0[2] * h0[2] + h0[3] * h0[3]) + (h1[0] * h1[0] + h1[1] * h1[1]) + (h1[2] * h1[2] + h1[3] * h1[3]);
                    *(u32x4*)(U2 + ro + bj * HALF) = pack8(h0, h1); }
                s += __shfl_xor(s, 16); s += __shfl_xor(s, 32);
                if (fq == 0) ssq[(size_t)row * 16 + u.pn * 4 + wc] = s; }
        }
    }
};
struct EpiFF1 {
    static constexpr bool PERM = true, AFTER_DRAIN = false;
    const float* ssq; bf16_t* Hd; int skip;
    __device__ __forceinline__ void operator()(const f32x4 (&acc)[2][2][4][2], const Unit& u, int wr, int wc, int fr, int fq) const {
        if (skip) { f32x4 t = {0.f, 0.f, 0.f, 0.f};
#pragma unroll
            for (int ai = 0; ai < 2; ++ai)
#pragma unroll
                for (int bj = 0; bj < 2; ++bj)
#pragma unroll
                    for (int m = 0; m < 4; ++m) t = t + acc[ai][bj][m][0] + acc[ai][bj][m][1];
            if (t[0] + t[1] + t[2] + t[3] == 123.456f) Hd[0] = 0; return; }
        const int row0 = u.pm * BM + wr * 64 + fr, col0 = u.pn * BM + wc * 32 + 8 * fq;
        f32x4 pv[2][4];
#pragma unroll
        for (int ai = 0; ai < 2; ++ai)
#pragma unroll
            for (int m = 0; m < 4; ++m) pv[ai][m] = *(const f32x4*)(ssq + (size_t)(row0 + ai * HALF + m * 16) * 16 + 4 * fq);
#pragma unroll
        for (int ai = 0; ai < 2; ++ai)
#pragma unroll
            for (int m = 0; m < 4; ++m) { const int row = row0 + ai * HALF + m * 16;
                const f32x4 p = pv[ai][m]; float s = (p[0] + p[1]) + (p[2] + p[3]);
                s += __shfl_xor(s, 16); s += __shfl_xor(s, 32);
                const float rstd = __builtin_amdgcn_rsqf(s * (1.0f / 1024.0f) + 1e-6f);
#pragma unroll
                for (int bj = 0; bj < 2; ++bj) { f32x4 v0 = acc[ai][bj][m][0] * rstd, v1 = acc[ai][bj][m][1] * rstd;
#pragma unroll
                    for (int e = 0; e < 4; ++e) { const float a = fmaxf(v0[e], 0.f), b = fmaxf(v1[e], 0.f); v0[e] = a * a; v1[e] = b * b; }
                    *(u32x4*)(Hd + (size_t)row * 4096 + col0 + bj * HALF) = pack8(v0, v1); } }
    }
};
struct EpiFF2 {
    static constexpr bool PERM = true, AFTER_DRAIN = false;
    const bf16_t* H1; bf16_t* H2;
    __device__ __forceinline__ void operator()(const f32x4 (&acc)[2][2][4][2], const Unit& u, int wr, int wc, int fr, int fq) const {
        const int row0 = u.pm * BM + wr * 64 + fr, col0 = u.pn * BM + wc * 32 + 8 * fq;
        u32x4 hv[2][4][2];
#pragma unroll
        for (int ai = 0; ai < 2; ++ai)
#pragma unroll
            for (int m = 0; m < 4; ++m)
#pragma unroll
                for (int bj = 0; bj < 2; ++bj) hv[ai][m][bj] = *(const u32x4*)(H1 + (size_t)(row0 + ai * HALF + m * 16) * 1024 + col0 + bj * HALF);
#pragma unroll
        for (int ai = 0; ai < 2; ++ai)
#pragma unroll
            for (int m = 0; m < 4; ++m)
#pragma unroll
                for (int bj = 0; bj < 2; ++bj) { const u32x4 t = hv[ai][m][bj];
                    const f32x4 v0 = acc[ai][bj][m][0] + (f32x4){bf_lo(t.x), bf_hi(t.x), bf_lo(t.y), bf_hi(t.y)}, v1 = acc[ai][bj][m][1] + (f32x4){bf_lo(t.z), bf_hi(t.z), bf_lo(t.w), bf_hi(t.w)};
                    *(u32x4*)(H2 + (size_t)(row0 + ai * HALF + m * 16) * 1024 + col0 + bj * HALF) = pack8(v0, v1); }
    }
};

template <class Epi, class Sched, bool ALIGN_EPI = false, bool SP2 = false>
__device__ __forceinline__ void gemm_phase(PG8_LAS unsigned char* lds, const Gemm g, const Sched& S, const Epi& E) {
    const int tid = threadIdx.x, wid = __builtin_amdgcn_readfirstlane(tid >> 6), lane = tid & 63, wr = wid >> 2, wc = wid & 3, fr = lane & 15, fq = lane >> 4;
    const int K = g.K, nt = K / BK;
    unsigned voffA[2], voffB[2];
#pragma unroll
    for (int i = 0; i < 2; ++i) { int R, C; stage_rc(tid * 16 + i * 8192, R, C); const int Rb = Epi::PERM ? ((R & ~31) + perm32(R & 31)) : R;
        voffA[i] = (unsigned)(R * K + C) * 2u; voffB[i] = (unsigned)(Rb * K + C) * 2u; }
    const size_t kstep = (size_t)(BK * 2);
    const size_t hstep = (size_t)HALF * K * 2;
    const size_t tstep = 2 * hstep;
    const unsigned ldsw = (unsigned)wid * 1024u;
    const int aoff = lds_byte(wr * 64 + fr, fq * 8), boff = lds_byte(wc * 32 + fr, fq * 8);
#define PG8_SA(b, h) (((b) * 2 + (h)) * HTB)
#define PG8_SB(b, h) ((4 + (b) * 2 + (h)) * HTB)
#define PG8_STAGE(bufoff, gbase, voff) do { _Pragma("unroll") for (int _i = 0; _i < 2; ++_i) \
        __builtin_amdgcn_global_load_lds((const unsigned*)((const char*)(gbase) + (voff)[_i]), (PG8_LAS unsigned*)(lds + (bufoff) + ldsw + _i * 8192), 16, 0, 0); } while (0)
#define PG8_LDA(dst, b, h) do { _Pragma("unroll") for (int m = 0; m < 4; ++m) _Pragma("unroll") for (int k = 0; k < 2; ++k) dst[m][k] = *(const PG8_LAS bf16x8*)(lds + PG8_SA(b, h) + aoff + m * 2048 + k * 1024); } while (0)
#define PG8_LDB(dst, b, h) do { _Pragma("unroll") for (int n = 0; n < 2; ++n) _Pragma("unroll") for (int k = 0; k < 2; ++k) dst[n][k] = *(const PG8_LAS bf16x8*)(lds + PG8_SB(b, h) + boff + n * 2048 + k * 1024); } while (0)
#define PG8_MMA(ai, bj, At, Bt) do { __builtin_amdgcn_s_setprio(1); _Pragma("unroll") for (int m = 0; m < 4; ++m) _Pragma("unroll") for (int n = 0; n < 2; ++n) _Pragma("unroll") for (int k = 0; k < 2; ++k) \
        acc[ai][bj][m][n] = __builtin_amdgcn_mfma_f32_16x16x32_bf16(Bt[n][k], At[m][k], acc[ai][bj][m][n], 0, 0, 0); __builtin_amdgcn_s_setprio(0); } while (0)
#define PG8_WAIT_V(n) asm volatile("s_waitcnt vmcnt(" #n ")" ::: "memory")
#define PG8_WAIT_L(n) asm volatile("s_waitcnt lgkmcnt(" #n ")" ::: "memory")
#define PG8_BAR __builtin_amdgcn_s_barrier()
#define PG8_SCHED __builtin_amdgcn_sched_barrier(0)
    Unit cur, nxt; int ui = 0;
    if (!S.next(0, cur)) return;
    f32x4 acc[2][2][4][2];
#pragma unroll
    for (int a = 0; a < 2; ++a)
#pragma unroll
        for (int b = 0; b < 2; ++b)
#pragma unroll
            for (int m = 0; m < 4; ++m)
#pragma unroll
                for (int n = 0; n < 2; ++n) acc[a][b][m][n] = (f32x4){0.f, 0.f, 0.f, 0.f};
    bf16x8 At[4][2], B0[2][2], B1[2][2];
    const char* cA = (const char*)g.A + (size_t)cur.pm * tstep; const char* cB = (const char*)g.Bt + (size_t)cur.pn * tstep;
    S.a_ready(cur);
    if constexpr (SP2) {
        PG8_STAGE(PG8_SB(0, 0), cB, voffB); PG8_STAGE(PG8_SB(0, 1), cB + hstep, voffB); PG8_STAGE(PG8_SA(0, 0), cA, voffA); PG8_STAGE(PG8_SA(0, 1), cA + hstep, voffA);
        if (wr == 1) PG8_BAR;
        PG8_WAIT_V(2); PG8_BAR;
        PG8_STAGE(PG8_SB(1, 0), cB + kstep, voffB); PG8_STAGE(PG8_SA(1, 0), cA + kstep, voffA); PG8_STAGE(PG8_SB(1, 1), cB + hstep + kstep, voffB);
        PG8_WAIT_V(6); PG8_BAR;
    } else {
        PG8_STAGE(PG8_SB(0, 0), cB, voffB); PG8_STAGE(PG8_SA(0, 0), cA, voffA); PG8_STAGE(PG8_SB(0, 1), cB + hstep, voffB); PG8_STAGE(PG8_SA(0, 1), cA + hstep, voffA);
        if (wr == 1) PG8_BAR;
        PG8_WAIT_V(4); PG8_BAR;
        PG8_STAGE(PG8_SB(1, 0), cB + kstep, voffB); PG8_STAGE(PG8_SA(1, 0), cA + kstep, voffA); PG8_STAGE(PG8_SB(1, 1), cB + hstep + kstep, voffB);
        PG8_WAIT_V(6); PG8_BAR;
    }
    for (;;) {
        const bool has_next = S.next(ui + 1, nxt);
        const char* nA = has_next ? (const char*)g.A + (size_t)nxt.pm * tstep : cA; const char* nB = has_next ? (const char*)g.Bt + (size_t)nxt.pn * tstep : cB;
        for (int t = 0; t < nt; t += 2) {
            const bool last = (t == nt - 2);
            const char* a1 = cA + (size_t)(t + 1) * kstep;
            const char* a2 = last ? nA : cA + (size_t)(t + 2) * kstep; const char* b2 = last ? nB : cB + (size_t)(t + 2) * kstep;
            const char* a3 = a2 + kstep; const char* b3 = b2 + kstep;
            if (last && has_next) S.a_ready(nxt);
            if constexpr (SP2) {
            PG8_LDB(B0, 0, 0); PG8_LDB(B1, 0, 1); PG8_SCHED; PG8_LDA(At, 0, 0); PG8_STAGE(PG8_SA(1, 1), a1 + hstep, voffA);
            PG8_WAIT_V(8); PG8_WAIT_L(0); PG8_BAR; PG8_MMA(0, 0, At, B0); PG8_MMA(0, 1, At, B1); PG8_BAR; PG8_SCHED;
            PG8_LDA(At, 0, 1); PG8_STAGE(PG8_SB(0, 0), b2, voffB); PG8_STAGE(PG8_SB(0, 1), b2 + hstep, voffB); PG8_STAGE(PG8_SA(0, 0), a2, voffA);
            PG8_WAIT_V(8); PG8_WAIT_L(0); PG8_BAR; PG8_MMA(1, 0, At, B0); PG8_MMA(1, 1, At, B1); PG8_BAR; PG8_SCHED;
            PG8_LDB(B0, 1, 0); PG8_LDB(B1, 1, 1); PG8_SCHED; PG8_LDA(At, 1, 0); PG8_STAGE(PG8_SA(0, 1), a2 + hstep, voffA);
            PG8_WAIT_V(8); PG8_WAIT_L(0); PG8_BAR; PG8_MMA(0, 0, At, B0); PG8_MMA(0, 1, At, B1); PG8_BAR; PG8_SCHED;
            PG8_LDA(At, 1, 1); PG8_STAGE(PG8_SB(1, 0), b3, voffB); PG8_STAGE(PG8_SB(1, 1), b3 + hstep, voffB); PG8_STAGE(PG8_SA(1, 0), a3, voffA);
            PG8_WAIT_V(8); PG8_WAIT_L(0); PG8_BAR; PG8_MMA(1, 0, At, B0); PG8_MMA(1, 1, At, B1); PG8_BAR; PG8_SCHED;
            } else {
            PG8_LDB(B0, 0, 0); PG8_SCHED; PG8_LDA(At, 0, 0); PG8_STAGE(PG8_SA(1, 1), a1 + hstep, voffA);
            PG8_WAIT_L(8); PG8_BAR; PG8_WAIT_L(0); PG8_MMA(0, 0, At, B0); PG8_BAR; PG8_SCHED;
            PG8_LDB(B1, 0, 1); PG8_STAGE(PG8_SB(0, 0), b2, voffB);
            PG8_BAR; PG8_WAIT_L(0); PG8_MMA(0, 1, At, B1); PG8_BAR;
            PG8_LDA(At, 0, 1); PG8_STAGE(PG8_SA(0, 0), a2, voffA);
            PG8_BAR; PG8_WAIT_L(0); PG8_MMA(1, 0, At, B0); PG8_BAR; PG8_SCHED;
            PG8_STAGE(PG8_SB(0, 1), b2 + hstep, voffB);
            PG8_WAIT_V(6); PG8_BAR; PG8_MMA(1, 1, At, B1); PG8_BAR;
            PG8_LDB(B0, 1, 0); PG8_SCHED; PG8_LDA(At, 1, 0); PG8_STAGE(PG8_SA(0, 1), a2 + hstep, voffA);
            PG8_WAIT_L(8); PG8_BAR; PG8_WAIT_L(0); PG8_MMA(0, 0, At, B0); PG8_BAR; PG8_SCHED;
            PG8_LDB(B1, 1, 1); PG8_STAGE(PG8_SB(1, 0), b3, voffB);
            PG8_BAR; PG8_WAIT_L(0); PG8_MMA(0, 1, At, B1); PG8_BAR;
            PG8_LDA(At, 1, 1); PG8_STAGE(PG8_SA(1, 0), a3, voffA);
            PG8_BAR; PG8_WAIT_L(0); PG8_MMA(1, 0, At, B0); PG8_BAR; PG8_SCHED;
            PG8_STAGE(PG8_SB(1, 1), b3 + hstep, voffB);
            PG8_WAIT_V(6); PG8_BAR; PG8_MMA(1, 1, At, B1); PG8_BAR;
            }
        }
        if constexpr (ALIGN_EPI) { if (wr == 0) PG8_BAR; }
        if constexpr (!Epi::AFTER_DRAIN) { E(acc, cur, wr, wc, fr, fq); S.done(cur); }
        if (!has_next) break;
#pragma unroll
        for (int a = 0; a < 2; ++a)
#pragma unroll
            for (int b = 0; b < 2; ++b)
#pragma unroll
                for (int m = 0; m < 4; ++m)
#pragma unroll
                    for (int n = 0; n < 2; ++n) acc[a][b][m][n] = (f32x4){0.f, 0.f, 0.f, 0.f};
        cur = nxt; cA = nA; cB = nB; ++ui;
        if constexpr (ALIGN_EPI) { if (wr == 1) PG8_BAR; }
    }
    PG8_WAIT_V(0);
    if constexpr (!ALIGN_EPI) { if (wr == 0) PG8_BAR; }
    PG8_BAR;
    if constexpr (Epi::AFTER_DRAIN) { E.fused(acc, cur, wr, wc, fr, fq, lds, wid, lane); S.done(cur); }
#undef PG8_SA
#undef PG8_SB
#undef PG8_STAGE
#undef PG8_LDA
#undef PG8_LDB
#undef PG8_MMA
#undef PG8_WAIT_V
#undef PG8_WAIT_L
#undef PG8_BAR
#undef PG8_SCHED
}
}
#ifndef PG8_SP2
#define PG8_SP2 true
#endif
#ifndef PG8_ALIGN
#define PG8_ALIGN true
#endif

constexpr int NWAVES = 8, NTHR = NWAVES * 64;
constexpr int D = 1024, BATCH = 32, SEQ = 2048, T = BATCH * SEQ, TP = T + 256, NZ = 4352, FF = 4096, W_IN_LD = 4112;
constexpr int NCHUNK = SEQ / 64;
constexpr int META_PAD = 48;
constexpr float EPS = 1e-6f;
constexpr size_t MiB = 1u << 20;
constexpr size_t WS_WIN = 0, WS_WA = 9 * MiB, WS_WB = 10 * MiB, WS_WO = 11 * MiB, WS_W1 = 13 * MiB, WS_W2 = 21 * MiB;
constexpr size_t WS_CTL = 29 * MiB, CTL_BYTES = 16384;
constexpr size_t WS_SSQ = 30 * MiB;
constexpr size_t WS_U = 34 * MiB;
constexpr size_t WS_Z = 163 * MiB;
constexpr size_t ZROW = (size_t)TP;
constexpr size_t WS_A = WS_Z, WS_Q = WS_A + ZROW * 512 * 2, WS_K = WS_Q + ZROW * 256 * 2, WS_V = WS_K + ZROW * 256 * 2, WS_R = WS_V + ZROW * 512 * 2,
                 WS_LA = WS_R + ZROW * 512 * 2, WS_GA = WS_LA + ZROW * 256 * 4, WS_GB = WS_GA + ZROW * 1024 * 2, WS_ZEND = WS_GB + ZROW * 1024 * 2;
constexpr size_t WS_PA = 742 * MiB, WS_ON = 806 * MiB, WS_U2 = 870 * MiB, WS_END = 998 * MiB;
constexpr size_t WS_HD = WS_Z;
static_assert(WS_ZEND <= WS_PA && WS_HD + (size_t)T * FF * 2 <= WS_PA && WS_U + ZROW * 2048 <= WS_Z, "ws map");
constexpr int LDS_BYTES = 132096;

#define GAS __attribute__((address_space(1)))
#define LAS __attribute__((address_space(3)))
typedef unsigned short bf16;
typedef unsigned v4u __attribute__((ext_vector_type(4)));
typedef unsigned v2u __attribute__((ext_vector_type(2)));
typedef float f32x4 __attribute__((ext_vector_type(4)));
typedef short bf16x8 __attribute__((ext_vector_type(8)));
using pg8::cvt_pk_bf16; using pg8::bf_lo; using pg8::bf_hi;
#define LDS_WAIT() asm volatile("s_waitcnt lgkmcnt(0)" ::: "memory")

__device__ __forceinline__ float wave_sum(float v) {
#pragma unroll
    for (int o = 1; o < 64; o <<= 1) v += __shfl_xor(v, o);
    return v;
}
__device__ __forceinline__ void tr_item(const float* W, int ldw, int src_col0, int K, int ncols, bf16* WT, int dst_row0, LAS float* scr, int item, int lane, const float* ks = nullptr) {
    const int nblk = ncols / 32, kb = item / nblk, nb = item % nblk, k0 = 64 * kb, n0 = 32 * nb;
#pragma unroll 8
    for (int i = 0; i < 32; ++i) { const int kk = 2 * i + (lane >> 5); scr[kk * 33 + (lane & 31)] = W[(size_t)(k0 + kk) * ldw + src_col0 + n0 + (lane & 31)] * (ks ? ks[k0 + kk] : 1.0f); }
    LDS_WAIT(); asm volatile("" ::: "memory");
    const int c = lane & 7;
#pragma unroll
    for (int j = 0; j < 4; ++j) { const int n = (lane >> 3) + 8 * j; const LAS float* s = scr + (8 * c) * 33 + n;
        v4u o; o.x = cvt_pk_bf16(s[0 * 33], s[1 * 33]); o.y = cvt_pk_bf16(s[2 * 33], s[3 * 33]); o.z = cvt_pk_bf16(s[4 * 33], s[5 * 33]); o.w = cvt_pk_bf16(s[6 * 33], s[7 * 33]);
        *(v4u*)(WT + (size_t)(dst_row0 + n0 + n) * K + k0 + 8 * c) = o; }
    LDS_WAIT(); asm volatile("" ::: "memory");
}
__device__ __forceinline__ void rms_row_to_bf16(const float* xrow, const f32x4 (&g)[4], bf16* orow, int lane) {
    const f32x4* xr = (const f32x4*)xrow + lane;
    f32x4 v[4]; float s = 0.f;
#pragma unroll
    for (int j = 0; j < 4; ++j) { v[j] = xr[64 * j]; s += (v[j].x * v[j].x + v[j].y * v[j].y) + (v[j].z * v[j].z + v[j].w * v[j].w); }
    const float rstd = __builtin_amdgcn_rsqf(wave_sum(s) * (1.f / D) + EPS);
    v2u* o8 = (v2u*)orow + lane;
#pragma unroll
    for (int j = 0; j < 4; ++j) { const f32x4 y = v[j] * rstd * g[j]; v2u w; w.x = cvt_pk_bf16(y.x, y.y); w.y = cvt_pk_bf16(y.z, y.w); o8[64 * j] = w; }
}

struct Ptrs {
    const float *x, *meta, *norm_mix, *w_in, *w_pool_mix, *pool_scale, *w_pool_out, *w_gate_up, *b_gate, *gla_norm, *w_gla_out, *w_out, *norm_ffn, *w_ff1, *w_ff2, *norm_final;
    float* out; unsigned char* ws;
};

__device__ __forceinline__ void p0_prologue(const Ptrs& P, LAS unsigned char* lds, int tid, int G) {
    const int lane = tid & 63, wave = tid >> 6;
    LAS float* scr = (LAS float*)(lds + wave * 16384);
    const int gw = blockIdx.x * NWAVES + wave, NGW = G * NWAVES;
    bf16* WIN = (bf16*)(P.ws + WS_WIN); bf16* WA = (bf16*)(P.ws + WS_WA); bf16* WB = (bf16*)(P.ws + WS_WB); bf16* WO = (bf16*)(P.ws + WS_WO);
    bf16* W1 = (bf16*)(P.ws + WS_W1); bf16* W2 = (bf16*)(P.ws + WS_W2); bf16* U = (bf16*)(P.ws + WS_U);
    constexpr int I_IN0 = 16 * 64, I_GA = 16 * 32, I_GB = 16 * 32, I_B = 8 * 32, I_O = 16 * 32, I_1 = 16 * 128, I_2 = 64 * 32;
    constexpr int NITEMS = I_IN0 + I_GA + I_GB + I_B + I_O + I_1 + I_2;
    for (int it = gw; it < NITEMS; it += NGW) {
        int r = it;
        if (r < I_IN0) { tr_item(P.w_in, W_IN_LD, 0, D, 2048, WIN, 0, scr, r, lane); continue; } r -= I_IN0;
        if (r < I_GA) { tr_item(P.w_in, W_IN_LD, 2064, D, 1024, WIN, 2304, scr, r, lane); continue; } r -= I_GA;
        if (r < I_GB) { tr_item(P.w_in, W_IN_LD, 3088, D, 1024, WIN, 3328, scr, r, lane); continue; } r -= I_GB;
        if (r < I_B) { tr_item(P.w_gla_out, D, 0, 512, 1024, WB, 0, scr, r, lane); continue; } r -= I_B;
        if (r < I_O) { tr_item(P.w_out, D, 0, D, 1024, WO, 0, scr, r, lane); continue; } r -= I_O;
        if (r < I_1) { tr_item(P.w_ff1, FF, 0, D, FF, W1, 0, scr, r, lane, P.norm_ffn); continue; } r -= I_1;
        tr_item(P.w_ff2, D, 0, FF, 1024, W2, 0, scr, r, lane);
    }
    const int gt = blockIdx.x * NTHR + tid, NGT = G * NTHR;
    for (int task = gt; task < 256 * 128; task += NGT) {
        const int j = task & 255, k0 = (task >> 8) * 8; float wg[16];
#pragma unroll
        for (int r = 0; r < 16; ++r) wg[r] = P.w_gate_up[r * 256 + j];
        float o[8];
#pragma unroll
        for (int i = 0; i < 8; ++i) { const f32x4* wr = (const f32x4*)(P.w_in + (size_t)(k0 + i) * W_IN_LD + 2048); float s = 0.f;
#pragma unroll
            for (int q = 0; q < 4; ++q) { const f32x4 w4 = wr[q]; s += w4.x * wg[4 * q] + w4.y * wg[4 * q + 1] + w4.z * wg[4 * q + 2] + w4.w * wg[4 * q + 3]; }
            o[i] = s; }
        v4u w; w.x = cvt_pk_bf16(o[0], o[1]); w.y = cvt_pk_bf16(o[2], o[3]); w.z = cvt_pk_bf16(o[4], o[5]); w.w = cvt_pk_bf16(o[6], o[7]);
        *(v4u*)(WIN + (size_t)(2048 + j) * D + k0) = w;
    }
    for (int task = gt; task < 1024 * 128; task += NGT) {
        const int n = task & 1023, c0 = (task >> 10) * 4, g = c0 >> 7, cl0 = c0 & 127; float o[4] = {0.f, 0.f, 0.f, 0.f};
        const float* wm = P.w_pool_mix + ((size_t)g * 128 + cl0) * 128; const float* wpo = P.w_pool_out + (size_t)(g * 128) * D + n; const float* sc = P.pool_scale + g * 128;
#pragma unroll 4
        for (int e = 0; e < 128; e += 4) {
            const f32x4 s4 = *(const f32x4*)(sc + e); f32x4 m4[4]; float wp[4];
#pragma unroll
            for (int q = 0; q < 4; ++q) wp[q] = wpo[(size_t)(e + q) * D];
#pragma unroll
            for (int i = 0; i < 4; ++i) m4[i] = *(const f32x4*)(wm + i * 128 + e);
#pragma unroll
            for (int q = 0; q < 4; ++q) { const float w = wp[q] * s4[q];
#pragma unroll
                for (int i = 0; i < 4; ++i) o[i] += m4[i][q] * w; }
        }
        v2u w; w.x = cvt_pk_bf16(o[0], o[1]); w.y = cvt_pk_bf16(o[2], o[3]);
        *(v2u*)(WA + (size_t)n * 512 + c0) = w;
    }
    f32x4 g[4];
#pragma unroll
    for (int j = 0; j < 4; ++j) g[j] = ((const f32x4*)P.norm_mix)[lane + 64 * j];
    for (int m0 = gw; m0 < T; m0 += 4 * NGW) {
        f32x4 v[4][4];
#pragma unroll
        for (int i = 0; i < 4; ++i) { const int m = m0 + i * NGW; const f32x4* xr = (const f32x4*)(P.x + (size_t)(m < T ? m : m0) * D) + lane;
#pragma unroll
            for (int j = 0; j < 4; ++j) v[i][j] = xr[64 * j]; }
#pragma unroll
        for (int i = 0; i < 4; ++i) { const int m = m0 + i * NGW; float s = 0.f;
#pragma unroll
            for (int j = 0; j < 4; ++j) s += (v[i][j].x * v[i][j].x + v[i][j].y * v[i][j].y) + (v[i][j].z * v[i][j].z + v[i][j].w * v[i][j].w);
            const float rstd = __builtin_amdgcn_rsqf(wave_sum(s) * (1.f / D) + EPS);
            if (m < T) { v2u* o8 = (v2u*)(U + (size_t)m * D) + lane;
#pragma unroll
                for (int j = 0; j < 4; ++j) { const f32x4 y = v[i][j] * rstd * g[j]; v2u w; w.x = cvt_pk_bf16(y.x, y.y); w.y = cvt_pk_bf16(y.z, y.w); o8[64 * j] = w; } } }
    }
    for (int m = gw; m < 256; m += NGW) {
        bf16* orow = U + (size_t)(T + m) * D;
        if (m >= META_PAD && m < META_PAD + 16) rms_row_to_bf16(P.meta + (size_t)(m - META_PAD) * D, g, orow, lane);
        else { v4u z = {0u, 0u, 0u, 0u}; ((v4u*)orow)[lane] = z; ((v4u*)orow)[lane + 64] = z; }
    }
}

constexpr int RS = 72;
__device__ __forceinline__ bf16x8 ldsv(const LAS bf16* p) { return *(const LAS bf16x8*)p; }
__device__ __forceinline__ void gla_item(LAS unsigned char* lds, int item, const bf16* Qg, const bf16* Kg, const bf16* Vg, const bf16* Rg, const bf16* LAg, const float* gn, bf16* ON, int tid) {
    const int b = item >> 2, h = item & 3;
    const int w = __builtin_amdgcn_readfirstlane(tid >> 6), lane = tid & 63, fr = lane & 15, fq = lane >> 4;
    LAS bf16* sQp = (LAS bf16*)lds; LAS bf16* sQm = sQp + 64 * RS; LAS bf16* sKm = sQm + 64 * RS; LAS bf16* sKp = sKm + 64 * RS; LAS bf16* sKeT = sKp + 64 * RS;
    LAS bf16* sVT = sKeT + 64 * RS; LAS bf16* sP = sVT + 128 * RS; LAS bf16* sST = sP + 64 * RS; LAS float* sD = (LAS float*)(sST + 128 * RS); LAS float* sSsq = sD + 64;
    const int tt = w & 3, vh = w >> 2;
    f32x4 Sacc[4], gnr[4];
#pragma unroll
    for (int j = 0; j < 4; ++j) { Sacc[j] = (f32x4){0.f, 0.f, 0.f, 0.f}; gnr[j] = *(const f32x4*)(gn + h * 128 + 64 * vh + 16 * j + 4 * fq); }
    v4u q8, k8, v16a, v16b, la8;
#ifdef EXP_NO_META
    for (int i = tid; i < 128 * RS / 2; i += NTHR) ((LAS unsigned*)sST)[i] = 0u;
    __syncthreads();
#endif
#define GLA_LOAD(c) do { const size_t row = ((c) == 0 ? (size_t)T : (size_t)b * SEQ + (size_t)((c) - 1) * 64) + lane; \
        q8 = *(const v4u*)(Qg + row * 256 + h * 64 + 8 * w); k8 = *(const v4u*)(Kg + row * 256 + h * 64 + 8 * w); \
        la8 = *(const v4u*)(LAg + row * 256 + h * 64 + 8 * w); \
        v16a = *(const v4u*)(Vg + row * 512 + h * 128 + 16 * w); v16b = *(const v4u*)(Vg + row * 512 + h * 128 + 16 * w + 8); } while (0)
#ifdef EXP_NO_META
    GLA_LOAD(1);
    for (int c = 1; c <= NCHUNK; ++c) {
#else
    GLA_LOAD(0);
    v2u ysave[4]; size_t orow_prev = 0;
    for (int c = 0; c <= NCHUNK; ++c) {
#endif
        float bc[8] = {bf_lo(la8.x), bf_hi(la8.x), bf_lo(la8.y), bf_hi(la8.y), bf_lo(la8.z), bf_hi(la8.z), bf_lo(la8.w), bf_hi(la8.w)};
        if (c == 0 && lane < META_PAD) {
#pragma unroll
            for (int i = 0; i < 8; ++i) bc[i] = 0.f; }
#pragma unroll
        for (int i = 0; i < 8; ++i) {
#pragma unroll
            for (int d = 1; d < 64; d <<= 1) { const float n = __shfl_up(bc[i], d); if (lane >= d) bc[i] += n; } }
        float qf[8] = {bf_lo(q8.x), bf_hi(q8.x), bf_lo(q8.y), bf_hi(q8.y), bf_lo(q8.z), bf_hi(q8.z), bf_lo(q8.w), bf_hi(q8.w)};
        float kf[8] = {bf_lo(k8.x), bf_hi(k8.x), bf_lo(k8.y), bf_hi(k8.y), bf_lo(k8.z), bf_hi(k8.z), bf_lo(k8.w), bf_hi(k8.w)};
        float qp[8], qm[8], km[8], kp[8], ke[8], dd[8];
#pragma unroll
        for (int i = 0; i < 8; ++i) { const float be = __shfl(bc[i], 63); const float eb = __expf(bc[i]), emb = __expf(-bc[i]), ek = __expf(be - bc[i]);
            qp[i] = qf[i] * eb; qm[i] = qf[i] * emb; km[i] = kf[i] * emb; kp[i] = kf[i] * eb; ke[i] = kf[i] * ek; dd[i] = __expf(be); }
        {
            v4u o;
            o.x = cvt_pk_bf16(qp[0], qp[1]); o.y = cvt_pk_bf16(qp[2], qp[3]); o.z = cvt_pk_bf16(qp[4], qp[5]); o.w = cvt_pk_bf16(qp[6], qp[7]); *(LAS v4u*)(sQp + lane * RS + 8 * w) = o;
            o.x = cvt_pk_bf16(qm[0], qm[1]); o.y = cvt_pk_bf16(qm[2], qm[3]); o.z = cvt_pk_bf16(qm[4], qm[5]); o.w = cvt_pk_bf16(qm[6], qm[7]); *(LAS v4u*)(sQm + lane * RS + 8 * w) = o;
            o.x = cvt_pk_bf16(km[0], km[1]); o.y = cvt_pk_bf16(km[2], km[3]); o.z = cvt_pk_bf16(km[4], km[5]); o.w = cvt_pk_bf16(km[6], km[7]); *(LAS v4u*)(sKm + lane * RS + 8 * w) = o;
            o.x = cvt_pk_bf16(kp[0], kp[1]); o.y = cvt_pk_bf16(kp[2], kp[3]); o.z = cvt_pk_bf16(kp[4], kp[5]); o.w = cvt_pk_bf16(kp[6], kp[7]); *(LAS v4u*)(sKp + lane * RS + 8 * w) = o;
        }
#pragma unroll
        for (int i = 0; i < 8; i += 2) { const unsigned pk = cvt_pk_bf16(ke[i], ke[i + 1]); sKeT[(8 * w + i) * RS + lane] = (bf16)(pk & 0xffffu); sKeT[(8 * w + i + 1) * RS + lane] = (bf16)(pk >> 16); }
        {
            const unsigned vv[8] = {v16a.x, v16a.y, v16a.z, v16a.w, v16b.x, v16b.y, v16b.z, v16b.w};
#pragma unroll
            for (int i = 0; i < 8; ++i) { sVT[(16 * w + 2 * i) * RS + lane] = (bf16)(vv[i] & 0xffffu); sVT[(16 * w + 2 * i + 1) * RS + lane] = (bf16)(vv[i] >> 16); }
        }
        if (lane == 0) {
#pragma unroll
            for (int i = 0; i < 8; ++i) sD[8 * w + i] = dd[i]; }
        if (c > 1) {
#pragma unroll
            for (int j = 0; j < 4; ++j) *(v2u*)(ON + orow_prev * 512 + h * 128 + 64 * vh + 16 * j + 4 * fq) = ysave[j]; }
        const int cn = (c < NCHUNK) ? c + 1 : c;
        GLA_LOAD(cn);
        v2u rr[4];
        const size_t orow = (size_t)b * SEQ + (size_t)(c > 0 ? c - 1 : 0) * 64 + 16 * tt + fr;
#pragma unroll
        for (int j = 0; j < 4; ++j) rr[j] = *(const v2u*)(Rg + orow * 512 + h * 128 + 64 * vh + 16 * j + 4 * fq);
        __syncthreads();
        f32x4 oacc[4];
#pragma unroll
        for (int j = 0; j < 4; ++j) oacc[j] = (f32x4){0.f, 0.f, 0.f, 0.f};
        if (c > 0) {
            const int st_t = w >> 1;
#pragma unroll
            for (int s2 = 0; s2 < 2; ++s2) { const int st = 2 * (w & 1) + s2; f32x4 a1 = {0.f, 0.f, 0.f, 0.f}, a2 = {0.f, 0.f, 0.f, 0.f};
                if (st <= st_t) {
#pragma unroll
                    for (int kk = 0; kk < 2; ++kk) a1 = __builtin_amdgcn_mfma_f32_16x16x32_bf16(ldsv(sKm + (16 * st + fr) * RS + 32 * kk + 8 * fq), ldsv(sQp + (16 * st_t + fr) * RS + 32 * kk + 8 * fq), a1, 0, 0, 0); }
                if (st >= st_t) {
#pragma unroll
                    for (int kk = 0; kk < 2; ++kk) a2 = __builtin_amdgcn_mfma_f32_16x16x32_bf16(ldsv(sKp + (16 * st + fr) * RS + 32 * kk + 8 * fq), ldsv(sQm + (16 * st_t + fr) * RS + 32 * kk + 8 * fq), a2, 0, 0, 0); }
                const int t = 16 * st_t + fr, s0 = 16 * st + 4 * fq; float p[4];
#pragma unroll
                for (int i = 0; i < 4; ++i) p[i] = (s0 + i <= t) ? a1[i] : a2[i];
                v2u o; o.x = cvt_pk_bf16(p[0], p[1]); o.y = cvt_pk_bf16(p[2], p[3]); *(LAS v2u*)(sP + t * RS + s0) = o; }
            {
                bf16x8 fs[4][2], fq2[2];
#pragma unroll
                for (int kk = 0; kk < 2; ++kk) fq2[kk] = ldsv(sQp + (16 * tt + fr) * RS + 32 * kk + 8 * fq);
#pragma unroll
                for (int j = 0; j < 4; ++j)
#pragma unroll
                    for (int kk = 0; kk < 2; ++kk) fs[j][kk] = ldsv(sST + (16 * (4 * vh + j) + fr) * RS + 32 * kk + 8 * fq);
#pragma unroll
                for (int j = 0; j < 4; ++j)
#pragma unroll
                    for (int kk = 0; kk < 2; ++kk) oacc[j] = __builtin_amdgcn_mfma_f32_16x16x32_bf16(fs[j][kk], fq2[kk], oacc[j], 0, 0, 0);
            }
        }
        __syncthreads();
        {
            bf16x8 fv[4][2], fp[2], fk[2];
#pragma unroll
            for (int j = 0; j < 4; ++j)
#pragma unroll
                for (int kk = 0; kk < 2; ++kk) fv[j][kk] = ldsv(sVT + (16 * (4 * vh + j) + fr) * RS + 32 * kk + 8 * fq);
#pragma unroll
            for (int kk = 0; kk < 2; ++kk) { fk[kk] = ldsv(sKeT + (16 * tt + fr) * RS + 32 * kk + 8 * fq); fp[kk] = ldsv(sP + (16 * tt + fr) * RS + 32 * kk + 8 * fq); }
            const f32x4 dv = *(const LAS f32x4*)(sD + 16 * tt + 4 * fq);
            if (c > 0) {
#pragma unroll
                for (int j = 0; j < 4; ++j)
#pragma unroll
                    for (int kk = 0; kk < 2; ++kk) oacc[j] = __builtin_amdgcn_mfma_f32_16x16x32_bf16(fv[j][kk], fp[kk], oacc[j], 0, 0, 0);
            }
#pragma unroll
            for (int j = 0; j < 4; ++j) { Sacc[j] = Sacc[j] * dv;
#pragma unroll
                for (int kk = 0; kk < 2; ++kk) Sacc[j] = __builtin_amdgcn_mfma_f32_16x16x32_bf16(fk[kk], fv[j][kk], Sacc[j], 0, 0, 0); }
#pragma unroll
            for (int j = 0; j < 4; ++j) { v2u o; o.x = cvt_pk_bf16(Sacc[j][0], Sacc[j][1]); o.y = cvt_pk_bf16(Sacc[j][2], Sacc[j][3]); *(LAS v2u*)(sST + (16 * (4 * vh + j) + fr) * RS + 16 * tt + 4 * fq) = o; }
        }
        float ss = 0.f;
#pragma unroll
        for (int j = 0; j < 4; ++j) ss += (oacc[j][0] * oacc[j][0] + oacc[j][1] * oacc[j][1]) + (oacc[j][2] * oacc[j][2] + oacc[j][3] * oacc[j][3]);
        ss += __shfl_xor(ss, 16); ss += __shfl_xor(ss, 32);
        if (fq == 0) sSsq[(16 * tt + fr) * 2 + vh] = ss;
        __syncthreads();
        if (c > 0) {
            const float tot = sSsq[(16 * tt + fr) * 2] + sSsq[(16 * tt + fr) * 2 + 1];
            const float rstd = __builtin_amdgcn_rsqf(tot * (1.0f / 128.0f) + EPS);
#pragma unroll
            for (int j = 0; j < 4; ++j) { const f32x4 rv = {bf_lo(rr[j].x), bf_hi(rr[j].x), bf_lo(rr[j].y), bf_hi(rr[j].y)}; const f32x4 y = oacc[j] * rstd * gnr[j] * rv;
                ysave[j].x = cvt_pk_bf16(y[0], y[1]); ysave[j].y = cvt_pk_bf16(y[2], y[3]); }
            orow_prev = orow;
        }
    }
#pragma unroll
    for (int j = 0; j < 4; ++j) *(v2u*)(ON + orow_prev * 512 + h * 128 + 64 * vh + 16 * j + 4 * fq) = ysave[j];
#undef GLA_LOAD
    __syncthreads();
}
__device__ __forceinline__ void pool_task(int task, const bf16* Ab, bf16* PA, int tid) {
    const int wave = tid >> 6, lane = tid & 63, b = task >> 3, i0 = (task & 7) * 256 + wave * 32;
    const int wd = 2 << (lane >> 4); const float inv = 1.0f / (float)wd;
    float sum[8];
#pragma unroll
    for (int e = 0; e < 8; ++e) sum[e] = 0.f;
#define AROW(i) ((i) >= 0 ? (size_t)b * SEQ + (size_t)(i) : (size_t)(T + 64 + (i)))
#define UNPK(w8, f) { f[0] = bf_lo(w8.x); f[1] = bf_hi(w8.x); f[2] = bf_lo(w8.y); f[3] = bf_hi(w8.y); f[4] = bf_lo(w8.z); f[5] = bf_hi(w8.z); f[6] = bf_lo(w8.w); f[7] = bf_hi(w8.w); }
    {
        v4u wv[15];
#pragma unroll
        for (int d = 1; d < 16; ++d) { const v4u z = {0u, 0u, 0u, 0u}; wv[d - 1] = (d < wd) ? *(const v4u*)(Ab + AROW(i0 - d) * 512 + 8 * lane) : z; }
#pragma unroll
        for (int d = 1; d < 16; ++d) { float f[8]; UNPK(wv[d - 1], f);
#pragma unroll
            for (int e = 0; e < 8; ++e) sum[e] += f[e]; }
    }
    for (int i4 = i0; i4 < i0 + 32; i4 += 8) {
        v4u c8[8], o8[8];
#pragma unroll
        for (int q = 0; q < 8; ++q) { c8[q] = *(const v4u*)(Ab + AROW(i4 + q) * 512 + 8 * lane); o8[q] = *(const v4u*)(Ab + AROW(i4 + q - wd + 1) * 512 + 8 * lane); }
#pragma unroll
        for (int q = 0; q < 8; ++q) { float cf[8], of[8], y[8]; UNPK(c8[q], cf); UNPK(o8[q], of);
#pragma unroll
            for (int e = 0; e < 8; ++e) { sum[e] += cf[e]; y[e] = sum[e] * inv - cf[e]; sum[e] -= of[e]; }
            v4u o; o.x = cvt_pk_bf16(y[0], y[1]); o.y = cvt_pk_bf16(y[2], y[3]); o.z = cvt_pk_bf16(y[4], y[5]); o.w = cvt_pk_bf16(y[6], y[7]);
            *(v4u*)(PA + ((size_t)b * SEQ + i4 + q) * 512 + 8 * lane) = o; }
    }
#undef AROW
#undef UNPK
}

#define XB_TMO      128
#define XB_XCNT(j)  (256  + 64 * (j))
#define XB_XSUB(j)  (1280 + 64 * (j))
#define XB_XGEN(j)  (2304 + 64 * (j))
#define XB_TOP      3328
#define XB_TOPGEN   3392
#define XCD_BAR_WORDS 3456
#define XB_SPIN_CAP (1u << 18)

__device__ __forceinline__ unsigned xb_ld(unsigned* p)              { return __hip_atomic_load(p, __ATOMIC_RELAXED, __HIP_MEMORY_SCOPE_AGENT); }
__device__ __forceinline__ unsigned xb_add(unsigned* p, unsigned v) { return __hip_atomic_fetch_add(p, v, __ATOMIC_RELAXED, __HIP_MEMORY_SCOPE_AGENT); }
__device__ __forceinline__ unsigned xb_xcc_id() { return (unsigned)__builtin_amdgcn_s_getreg((3 << 11) | 20) & 0xFu; }
#define XB_SPIN(cond, bar) do { unsigned _sp = 0; while (cond) { __builtin_amdgcn_s_sleep(1); \
    if ((++_sp & 255u) == 0u) { if (xb_ld(&(bar)[XB_TMO])) break; if (_sp > XB_SPIN_CAP) { atomicAdd(&(bar)[XB_TMO], 1u); break; } } } } while (0)

struct XcdBarrier {
    unsigned* bar; unsigned x;
    volatile LAS unsigned* st;
};

__device__ __forceinline__ XcdBarrier xcd_barrier_post(unsigned* bar, volatile LAS unsigned* st) {
    XcdBarrier b; b.bar = bar; b.x = xb_xcc_id(); b.st = st;
    if (threadIdx.x == 0) (void)xb_add(&bar[XB_XCNT(b.x)], 1u);
    return b;
}
__device__ __forceinline__ void xcd_barrier_complete(unsigned* bar, unsigned x, unsigned& nloc, unsigned& nx) {
    const unsigned G = gridDim.x * gridDim.y * gridDim.z;
    unsigned sum, cnt, mine, sp = 0u;
    for (;;) {
        sum = 0u; cnt = 0u; mine = 0u;
#pragma unroll
        for (unsigned j = 0; j < 16; ++j) { const unsigned c = xb_ld(&bar[XB_XCNT(j)]); sum += c; cnt += (c > 0u) ? 1u : 0u; mine = (j == x) ? c : mine; }
        if (sum == G) break;
        __builtin_amdgcn_s_sleep(1);
        if ((++sp & 255u) == 0u) { if (xb_ld(&bar[XB_TMO])) break; if (sp > XB_SPIN_CAP) { atomicAdd(&bar[XB_TMO], 1u); break; } }
    }
    nloc = mine > 0u ? mine : 1u; nx = cnt > 0u ? cnt : 1u;
}

__device__ __forceinline__ void xcd_barrier(const XcdBarrier& b) {
    asm volatile("s_waitcnt vmcnt(0)" ::: "memory");
    __syncthreads();
    if (threadIdx.x == 0) {
        unsigned* bar = b.bar;
        __builtin_amdgcn_s_waitcnt(0);
        unsigned nloc = b.st[0], nx = b.st[1];
        if (nloc == 0u) { xcd_barrier_complete(bar, b.x, nloc, nx); b.st[0] = nloc; b.st[1] = nx; }
        const unsigned old = xb_add(&bar[XB_XSUB(b.x)], 1u);
        const unsigned gen = old / nloc;
        if (old + 1u == (gen + 1u) * nloc) {
            __builtin_amdgcn_fence(__ATOMIC_RELEASE, "agent");
            asm volatile("s_waitcnt vmcnt(0)" ::: "memory");
            const unsigned og = xb_add(&bar[XB_TOP], 1u);
            const unsigned tg = og / nx;
            if (og + 1u == (tg + 1u) * nx) xb_add(&bar[XB_TOPGEN], 1u);
            else XB_SPIN(xb_ld(&bar[XB_TOPGEN]) == tg, bar);
            __builtin_amdgcn_fence(__ATOMIC_ACQUIRE, "agent");
            xb_add(&bar[XB_XGEN(b.x)], 1u);
            asm volatile("s_waitcnt vmcnt(0)" ::: "memory");
        } else {
            XB_SPIN(xb_ld(&bar[XB_XGEN(b.x)]) == gen, bar);
            __builtin_amdgcn_fence(__ATOMIC_ACQUIRE, "agent");
            asm volatile("s_waitcnt vmcnt(0)" ::: "memory");
        }
    }
    __syncthreads();
}

#define WSP(T_, off) ((T_*)(P.ws + (off)))
#ifndef STAGGER_TICKS
#define STAGGER_TICKS 0
#endif
__device__ __forceinline__ void stagger(const pg8::StaticOrder& S) {
    if (STAGGER_TICKS <= 0) return;
    pg8::Unit u0; if (!S.next(0, u0)) return;
    const unsigned long long t0 = __builtin_amdgcn_s_memrealtime();
    const unsigned long long wait = (unsigned long long)(u0.pm & 7) * STAGGER_TICKS;
    while (__builtin_amdgcn_s_memrealtime() - t0 < wait) __builtin_amdgcn_s_sleep(4);
}
__device__ __forceinline__ void phase_1(const Ptrs& P, LAS unsigned char* lds, int tid, int G) {
    pg8::Gemm g{WSP(bf16, WS_U), WSP(bf16, WS_WIN), TP, NZ, D}; pg8::StaticOrder S; S.init(TP, NZ, G, (int)blockIdx.x); stagger(S);
    pg8::EpiZ E{WSP(bf16, WS_A), WSP(bf16, WS_Q), WSP(bf16, WS_K), WSP(bf16, WS_V), WSP(bf16, WS_R), WSP(bf16, WS_LA), WSP(unsigned char, WS_GA), WSP(unsigned char, WS_GB), P.b_gate};
    pg8::gemm_phase<pg8::EpiZ, pg8::StaticOrder, PG8_ALIGN, PG8_SP2>(lds, g, S, E);
}
__device__ __forceinline__ bool p2_fused(int G) { return G == 256; }
__device__ __forceinline__ void phase_2(const Ptrs& P, LAS unsigned char* lds, int tid, int G) {
    for (int item = blockIdx.x; item < BATCH * 4; item += G) gla_item(lds, item, WSP(bf16, WS_Q), WSP(bf16, WS_K), WSP(bf16, WS_V), WSP(bf16, WS_R), WSP(bf16, WS_LA), P.gla_norm, WSP(bf16, WS_ON), tid);
    if (p2_fused(G)) {
        if (blockIdx.x >= 128) {
            const int p0 = (int)blockIdx.x - 128, p1 = p0 + 128;
            pool_task(p0, WSP(bf16, WS_A), WSP(bf16, WS_PA), tid); pool_task(p1, WSP(bf16, WS_A), WSP(bf16, WS_PA), tid);
            __builtin_amdgcn_fence(__ATOMIC_RELEASE, "agent"); asm volatile("s_waitcnt vmcnt(0)" ::: "memory"); __syncthreads(); __builtin_amdgcn_fence(__ATOMIC_ACQUIRE, "agent");
            pg8::Gemm g{WSP(bf16, WS_PA), WSP(bf16, WS_WA), T, D, 512}; pg8::PanelOrder S{p0, p1};
            pg8::EpiGate<false> E{WSP(unsigned char, WS_GA), WSP(bf16, WS_U)};
            pg8::gemm_phase<pg8::EpiGate<false>, pg8::PanelOrder, PG8_ALIGN, PG8_SP2>(lds, g, S, E);
        }
    }
    else if (G > 128) { for (int task = (int)blockIdx.x - 128; task >= 0 && task < 256; task += G - 128) pool_task(task, WSP(bf16, WS_A), WSP(bf16, WS_PA), tid); }
    else { for (int task = blockIdx.x; task < 256; task += G) pool_task(task, WSP(bf16, WS_A), WSP(bf16, WS_PA), tid); }
}
__device__ __forceinline__ void phase_3(const Ptrs& P, LAS unsigned char* lds, int tid, int G) {
    pg8::Gemm g{WSP(bf16, WS_PA), WSP(bf16, WS_WA), T, D, 512}; pg8::StaticOrder S; S.init(T, D, G, (int)blockIdx.x); stagger(S);
    pg8::EpiGate<false> E{WSP(unsigned char, WS_GA), WSP(bf16, WS_U)};
    pg8::gemm_phase<pg8::EpiGate<false>, pg8::StaticOrder, PG8_ALIGN, PG8_SP2>(lds, g, S, E);
}
__device__ __forceinline__ void phase_4(const Ptrs& P, LAS unsigned char* lds, int tid, int G) {
    pg8::Gemm g{WSP(bf16, WS_ON), WSP(bf16, WS_WB), T, D, 512}; pg8::StaticOrder S; S.init(T, D, G, (int)blockIdx.x); stagger(S);
    pg8::EpiGate<true> E{WSP(unsigned char, WS_GB), WSP(bf16, WS_U)};
    pg8::gemm_phase<pg8::EpiGate<true>, pg8::StaticOrder, PG8_ALIGN, PG8_SP2>(lds, g, S, E);
}
__device__ __forceinline__ void phase_5(const Ptrs& P, LAS unsigned char* lds, int tid, int G) {
    pg8::Gemm g{WSP(bf16, WS_U), WSP(bf16, WS_WO), T, D, D}; pg8::StaticOrder S; S.init(T, D, G, (int)blockIdx.x); stagger(S);
    pg8::EpiOut E{P.x, WSP(bf16, WS_U2), WSP(float, WS_SSQ)};
    pg8::gemm_phase<pg8::EpiOut, pg8::StaticOrder, PG8_ALIGN, PG8_SP2>(lds, g, S, E);
}
__device__ __forceinline__ void phase_6(const Ptrs& P, LAS unsigned char* lds, int tid, int G, int skip = 0) {
    pg8::Gemm g{WSP(bf16, WS_U2), WSP(bf16, WS_W1), T, FF, D}; pg8::StaticOrder S; S.init(T, FF, G, (int)blockIdx.x); stagger(S);
    pg8::EpiFF1 E{WSP(float, WS_SSQ), WSP(bf16, WS_HD), skip};
    pg8::gemm_phase<pg8::EpiFF1, pg8::StaticOrder, PG8_ALIGN, PG8_SP2>(lds, g, S, E);
}
__device__ __forceinline__ void phase_7(const Ptrs& P, LAS unsigned char* lds, int tid, int G) {
    pg8::Gemm g{WSP(bf16, WS_HD), WSP(bf16, WS_W2), T, D, FF}; pg8::StaticOrder S; S.init(T, D, G, (int)blockIdx.x); stagger(S);
    pg8::EpiFF2 E{WSP(bf16, WS_U2), WSP(bf16, WS_U)};
    pg8::gemm_phase<pg8::EpiFF2, pg8::StaticOrder, PG8_ALIGN, PG8_SP2>(lds, g, S, E);
}
__device__ __forceinline__ void phase_8(const Ptrs& P, LAS unsigned char* lds, int tid, int G) {
    const int lane = tid & 63, gw = blockIdx.x * NWAVES + (tid >> 6), NGW = G * NWAVES;
    const bf16* H2 = WSP(bf16, WS_U);
    f32x4 g[2][2];
#pragma unroll
    for (int q = 0; q < 2; ++q)
#pragma unroll
        for (int n = 0; n < 2; ++n) g[q][n] = *(const f32x4*)(P.norm_final + 512 * q + 8 * lane + 4 * n);
    for (int m0 = gw; m0 < T; m0 += 8 * NGW) {
        v4u hv[8][2];
#pragma unroll
        for (int i = 0; i < 8; ++i) { const int m = m0 + i * NGW; const v4u* hr = (const v4u*)(H2 + (size_t)(m < T ? m : m0) * D) + lane; hv[i][0] = hr[0]; hv[i][1] = hr[64]; }
#pragma unroll
        for (int i = 0; i < 8; ++i) { const int m = m0 + i * NGW; f32x4 v[2][2]; float s = 0.f;
#pragma unroll
            for (int q = 0; q < 2; ++q) { const v4u t = hv[i][q]; v[q][0] = (f32x4){bf_lo(t.x), bf_hi(t.x), bf_lo(t.y), bf_hi(t.y)}; v[q][1] = (f32x4){bf_lo(t.z), bf_hi(t.z), bf_lo(t.w), bf_hi(t.w)};
#pragma unroll
                for (int n = 0; n < 2; ++n) s += (v[q][n].x * v[q][n].x + v[q][n].y * v[q][n].y) + (v[q][n].z * v[q][n].z + v[q][n].w * v[q][n].w); }
            const float rstd = __builtin_amdgcn_rsqf(wave_sum(s) * (1.f / D) + EPS);
            if (m < T) { float* xo = P.out + (size_t)m * D + 8 * lane;
#pragma unroll
                for (int q = 0; q < 2; ++q)
#pragma unroll
                    for (int n = 0; n < 2; ++n) *(f32x4*)(xo + 512 * q + 4 * n) = v[q][n] * rstd * g[q][n]; } }
    }
}
__device__ __forceinline__ void phase_0(const Ptrs& P, LAS unsigned char* lds, int tid, int G) { p0_prologue(P, lds, tid, G); __syncthreads(); }

struct Args { Ptrs p; int ph_lo, ph_hi, coop, pad; };
__global__ void __launch_bounds__(NTHR, 2) hybrid_fwd(Args args) {
    extern __shared__ __attribute__((aligned(16))) unsigned char lds_raw[];
    cg::grid_group grid = cg::this_grid();
    LAS unsigned char* lds = (LAS unsigned char*)lds_raw;
    const Ptrs& P = args.p;
    const int tid = threadIdx.x, G = gridDim.x, lo = args.ph_lo, hi = args.ph_hi;
    volatile LAS unsigned* bst = (volatile LAS unsigned*)(lds + 131072);
    if (tid < 2) bst[tid] = 0u;
    __syncthreads();
    XcdBarrier bar; bar.bar = (unsigned*)(P.ws + WS_CTL); bar.x = 0; bar.st = bst;
    if (args.coop == 1) bar = xcd_barrier_post((unsigned*)(P.ws + WS_CTL), bst);
#define GSYNC() do { if (args.coop == 1) xcd_barrier(bar); else grid.sync(); } while (0)
#define IN(k) (lo <= (k) && (k) < hi)
#define SEAM(k) do { if (IN(k) && IN((k) + 1)) GSYNC(); } while (0)
#define DUP(k, body) do { if ((PROBE_DUP >> (k)) & 1) { GSYNC(); body; } } while (0)
    if (IN(0)) phase_0(P, lds, tid, G);
    DUP(0, phase_0(P, lds, tid, G));
    SEAM(0);
    if (IN(1)) phase_1(P, lds, tid, G);
    DUP(1, phase_1(P, lds, tid, G));
    SEAM(1);
    if (IN(2)) phase_2(P, lds, tid, G);
    DUP(2, phase_2(P, lds, tid, G));
    SEAM(2);
    if (IN(3) && !p2_fused(G)) phase_3(P, lds, tid, G);
    if (!p2_fused(G)) SEAM(3);
    if (IN(4)) phase_4(P, lds, tid, G);
    DUP(4, { phase_3(P, lds, tid, G); GSYNC(); phase_4(P, lds, tid, G); });
    SEAM(4);
    if (IN(5)) phase_5(P, lds, tid, G);
    DUP(5, phase_5(P, lds, tid, G));
    SEAM(5);
    if (IN(6)) phase_6(P, lds, tid, G);
    DUP(6, phase_6(P, lds, tid, G, 1));
    SEAM(6);
    if (IN(7)) phase_7(P, lds, tid, G);
    DUP(7, { phase_5(P, lds, tid, G); GSYNC(); phase_7(P, lds, tid, G); });
    SEAM(7);
    if (IN(8)) phase_8(P, lds, tid, G);
#undef IN
#undef SEAM
#undef DUP
}

constexpr int N_PHASES = 9;
extern "C" void kernel_launch(void* const* d_in, const int* in_sizes, int n_in, void* d_out, int out_size, void* d_ws, size_t ws_size, hipStream_t stream) {
    static int grid = 0;
    if (grid == 0) {
        if (n_in != 16 || in_sizes[0] != T * D || out_size != T * D || ws_size < WS_END) { fprintf(stderr, "kernel_launch: unexpected shapes (n_in %d in0 %d out %d ws %zu)\n", n_in, n_in > 0 ? in_sizes[0] : -1, out_size, ws_size); grid = -1; return; }
        int dev = 0, cus = 0, per_cu = 0;
        hipGetDevice(&dev); hipDeviceGetAttribute(&cus, hipDeviceAttributeMultiprocessorCount, dev);
        if (hipFuncSetAttribute((const void*)hybrid_fwd, hipFuncAttributeMaxDynamicSharedMemorySize, LDS_BYTES) != hipSuccess) { fprintf(stderr, "kernel_launch: hipFuncSetAttribute failed\n"); grid = -1; return; }
        if (hipOccupancyMaxActiveBlocksPerMultiprocessor(&per_cu, (const void*)hybrid_fwd, NTHR, LDS_BYTES) != hipSuccess || per_cu < 1) { fprintf(stderr, "kernel_launch: occupancy query says %d\n", per_cu); per_cu = 1; }
        (void)hipGetLastError();
        grid = cus * 1;
        if (grid <= 0) grid = 256;
    }
    if (grid < 0) return;
    Args a{};
    Ptrs& p = a.p;
    p.x = (const float*)d_in[0]; p.meta = (const float*)d_in[1]; p.norm_mix = (const float*)d_in[2]; p.w_in = (const float*)d_in[3]; p.w_pool_mix = (const float*)d_in[4];
    p.pool_scale = (const float*)d_in[5]; p.w_pool_out = (const float*)d_in[6]; p.w_gate_up = (const float*)d_in[7]; p.b_gate = (const float*)d_in[8]; p.gla_norm = (const float*)d_in[9];
    p.w_gla_out = (const float*)d_in[10]; p.w_out = (const float*)d_in[11]; p.norm_ffn = (const float*)d_in[12]; p.w_ff1 = (const float*)d_in[13]; p.w_ff2 = (const float*)d_in[14];
    p.norm_final = (const float*)d_in[15]; p.out = (float*)d_out; p.ws = (unsigned char*)d_ws;
#if MK_N_LAUNCHES == 1
    if (hipMemsetAsync((char*)d_ws + WS_CTL, 0, CTL_BYTES, stream) != hipSuccess) { fprintf(stderr, "kernel_launch: memset of the barrier words failed\n"); return; }
    a.ph_lo = 0; a.ph_hi = N_PHASES; a.coop = 1;
    void* kargs[] = {&a};
    hipError_t e = hipLaunchCooperativeKernel((const void*)hybrid_fwd, dim3(grid), dim3(NTHR), kargs, LDS_BYTES, stream);
    if (e != hipSuccess) fprintf(stderr, "kernel_launch: cooperative launch failed: %s (grid %d)\n", hipGetErrorString(e), grid);
#else
    for (int ph = 0; ph < N_PHASES; ++ph) { a.ph_lo = ph; a.ph_hi = ph + 1; a.coop = 0;
        hipLaunchKernelGGL(hybrid_fwd, dim3(grid), dim3(NTHR), LDS_BYTES, stream, a); }
#endif
}
```
